# Optimizing an MI355X kernel written in HIP

```python
import math
import jax, jax.numpy as jnp
from jax import lax
import numpy as np

D_MODEL = 1024
BATCH = 16
SEQ = 256
DEPTH = 4
DEC_BATCH = 8
DEC_SEQ = 1024
PAST_LEN = 256

GRID_W = 64
N_MIXERS = 3
N_POOL = (DEPTH + 2) // 3
N_MLA = (DEPTH + 1) // 3
N_LRU = DEPTH // 3
POOL_WINDOWS = (2, 4, 8, 16)
POOL_GROUPS = 4
POOL_GC = D_MODEL // POOL_GROUPS
MLA_HEADS = 8
Q_LORA = 384
KV_LORA = 256
QK_NOPE = 128
QK_ROPE = 64
V_HEAD = 128
ROPE_NF = QK_ROPE // 4
ROPE_THETA = 10000.0
MLA_SCALE = (QK_NOPE + QK_ROPE) ** -0.5
DENSE_KEY_LIMIT = 2048
Q_BLOCK = 128
D_RNN = D_MODEL
LRU_BLOCKS = 8
LRU_BW = D_RNN // LRU_BLOCKS
CONV_W = 4
CONV_LEFT = 1
LRU_C = 8.0
D_FF = ((8 * D_MODEL // 3 + 255) // 256) * 256
ALPHA = (2.0 * DEPTH) ** 0.25
BETA = (8.0 * DEPTH) ** -0.25
EPS = 1e-6

kernel_name = 'hybrid_pool_mla_rglru_diffusion_step'


def layer_norm(x, g, b):
    x32 = x.astype(jnp.float32)
    mu = jnp.mean(x32, axis=-1, keepdims=True)
    var = jnp.mean(jnp.square(x32 - mu), axis=-1, keepdims=True)
    y = (x32 - mu) * lax.rsqrt(var + EPS)
    return (y * g.astype(jnp.float32) + b.astype(jnp.float32)).astype(x.dtype)


def rms_norm(x, g):
    x32 = x.astype(jnp.float32)
    y = x32 * lax.rsqrt(jnp.mean(jnp.square(x32), axis=-1, keepdims=True) + EPS)
    return (y * g.astype(jnp.float32)).astype(x.dtype)


def modulation(cond, w_ada, b_ada):
    m = (jax.nn.silu(cond) @ w_ada + b_ada)[:, None, :]
    return jnp.split(m, 6, axis=-1)


def swiglu(h, w_in, w_out):
    a, b = jnp.split(h @ w_in, 2, axis=-1)
    return (jax.nn.silu(a) * b) @ w_out


def rope_tables(T):
    t = jnp.arange(T)
    rows = (t // GRID_W).astype(jnp.float32)
    cols = (t % GRID_W).astype(jnp.float32)
    inv = ROPE_THETA ** (-jnp.arange(ROPE_NF, dtype=jnp.float32) / ROPE_NF)
    ang = jnp.stack([rows[:, None] * inv, cols[:, None] * inv], axis=1)
    return jnp.cos(ang), jnp.sin(ang)


def apply_rope(x, cos, sin):
    xr = x.reshape(x.shape[:-1] + (2, 2, ROPE_NF)).astype(jnp.float32)
    x1, x2 = xr[..., 0, :], xr[..., 1, :]
    out = jnp.stack([x1 * cos - x2 * sin, x2 * cos + x1 * sin], axis=-2)
    return out.reshape(x.shape).astype(x.dtype)


def pool_mix(x, w_pool, scale):
    B, T, D = x.shape
    x32 = x.astype(jnp.float32)
    csum = jnp.concatenate([jnp.zeros((B, 1, D), jnp.float32), jnp.cumsum(x32, axis=1)], axis=1)
    t = jnp.arange(T)
    groups = []
    for g, w in enumerate(POOL_WINDOWS):
        lo = jnp.clip(t - w // 2, 0, T)
        hi = jnp.clip(t + w - w // 2, 0, T)
        cg = csum[..., g * POOL_GC:(g + 1) * POOL_GC]
        cnt = (hi - lo).astype(jnp.float32)[:, None]
        groups.append((jnp.take(cg, hi, axis=1) - jnp.take(cg, lo, axis=1)) / cnt)
    pooled = jnp.stack(groups, axis=2) - x32.reshape(B, T, POOL_GROUPS, POOL_GC)
    out = jnp.einsum('btgc,gcd->btgd', pooled.astype(x.dtype), w_pool).reshape(B, T, D)
    return out * scale


def mla_project(x, w_dq, g_q, w_uq, w_dkv, g_kv):
    q = jnp.einsum('btr,rhe->bthe', rms_norm(x @ w_dq, g_q), w_uq)
    kv = x @ w_dkv
    c_kv = rms_norm(kv[..., :KV_LORA], g_kv)
    return q[..., :QK_NOPE], q[..., QK_NOPE:], c_kv, kv[..., KV_LORA:]


def mla_attend(q_nope, q_rope, c_kv, k_rope, w_uk, w_uv, w_o):
    B, T = q_nope.shape[:2]
    k_nope = jnp.einsum('bsr,rhe->bshe', c_kv, w_uk)
    v = jnp.einsum('bsr,rhe->bshe', c_kv, w_uv)

    def attend(qn, qr):
        s = jnp.einsum('bthe,bshe->bhts', qn, k_nope) + jnp.einsum('bthe,bse->bhts', qr, k_rope)
        p = jax.nn.softmax(s.astype(jnp.float32) * MLA_SCALE, axis=-1).astype(v.dtype)
        return jnp.einsum('bhts,bshe->bthe', p, v)

    if k_nope.shape[1] >= DENSE_KEY_LIMIT and T % Q_BLOCK == 0:
        nb = T // Q_BLOCK
        blk = lambda a: jnp.moveaxis(a.reshape((B, nb, Q_BLOCK) + a.shape[2:]), 1, 0)
        o = lax.map(lambda qs: attend(qs[0], qs[1]), (blk(q_nope), blk(q_rope)))
        o = jnp.moveaxis(o, 0, 1).reshape(B, T, MLA_HEADS, V_HEAD)
    else:
        o = attend(q_nope, q_rope)
    return o.reshape(B, T, MLA_HEADS * V_HEAD) @ w_o


def linear_scan(a, b, h0, reverse):
    if reverse:
        b = b.at[:, -1].add(a[:, -1] * h0)
    else:
        b = b.at[:, 0].add(a[:, 0] * h0)
    combine = lambda e1, e2: (e1[0] * e2[0], e2[0] * e1[1] + e2[1])
    _, h = lax.associative_scan(combine, (a, b), axis=1, reverse=reverse)
    return h


def lru_mixer(x, w_in, conv_w, conv_b, w_a, b_a, w_i, b_i, lam, w_out, h0_f, h0_b):
    B, T, _ = x.shape
    xy = x @ w_in
    u, y = xy[..., :D_RNN], jax.nn.gelu(xy[..., D_RNN:])
    up = jnp.pad(u, ((0, 0), (CONV_LEFT, CONV_W - 1 - CONV_LEFT), (0, 0)))
    u = sum(up[:, k:k + T] * conv_w[k] for k in range(CONV_W)) + conv_b
    u32 = u.astype(jnp.float32)
    ub = u32.reshape(B, T, LRU_BLOCKS, LRU_BW)
    r = jax.nn.sigmoid(jnp.einsum('btnc,dncm->dbtnm', ub, w_a.astype(jnp.float32)).reshape(2, B, T, D_RNN)
                       + b_a.astype(jnp.float32)[:, None, None])
    ig = jax.nn.sigmoid(jnp.einsum('btnc,dncm->dbtnm', ub, w_i.astype(jnp.float32)).reshape(2, B, T, D_RNN)
                        + b_i.astype(jnp.float32)[:, None, None])
    log_a = -LRU_C * r * jax.nn.softplus(-lam.astype(jnp.float32))[:, None, None]
    a = jnp.exp(log_a)
    bterm = jnp.sqrt(-jnp.expm1(2.0 * log_a)) * (ig * u32[None])
    h_f = linear_scan(a[0], bterm[0], h0_f.astype(jnp.float32), reverse=False)
    h_b = linear_scan(a[1], bterm[1], h0_b.astype(jnp.float32), reverse=True)
    out = ((h_f + h_b).astype(x.dtype) * y) @ w_out
    return out, h_f[:, -1].astype(x.dtype), h_b[:, 0].astype(x.dtype)


def setup_inputs(seed: int = 0) -> dict:
    key = jax.random.key(seed)
    ks = iter(jax.random.split(key, 40))
    nrm = lambda shape, s=1.0: jax.random.normal(next(ks), shape, jnp.float32) * s
    d = D_MODEL
    u = jax.random.uniform(next(ks), (N_LRU, 2, D_RNN), jnp.float32, 0.9, 0.999)
    a0 = u ** (1.0 / LRU_C)
    return {
        'x_prompt': nrm((BATCH, SEQ, d)),
        'x_sample': nrm((DEC_BATCH, DEC_SEQ, d)),
        'cache_mla_ckv': nrm((DEC_BATCH, N_MLA, PAST_LEN, KV_LORA)),
        'cache_mla_krope': nrm((DEC_BATCH, N_MLA, PAST_LEN, QK_ROPE)),
        'state_lru': nrm((DEC_BATCH, N_LRU, 2, D_RNN), 0.5),
        'c': nrm((DEC_BATCH, d)),
        'c_ctx': nrm((d,)),
        'w_ada': nrm((DEPTH, d, 6 * d), d ** -0.5),
        'b_ada': nrm((DEPTH, 6 * d), 0.02),
        'ln_g': 1.0 + nrm((DEPTH, 2, d), 0.02),
        'ln_b': nrm((DEPTH, 2, d), 0.02),
        'w_ffn_in': nrm((DEPTH, d, 2 * D_FF), d ** -0.5),
        'w_ffn_out': nrm((DEPTH, D_FF, d), BETA * D_FF ** -0.5),
        'w_pool': nrm((N_POOL, POOL_GROUPS, POOL_GC, POOL_GC), BETA * POOL_GC ** -0.5),
        'pool_scale': 1.0 + nrm((N_POOL, d), 0.02),
        'w_dq': nrm((N_MLA, d, Q_LORA), d ** -0.5),
        'g_q': 1.0 + nrm((N_MLA, Q_LORA), 0.02),
        'w_uq': nrm((N_MLA, Q_LORA, MLA_HEADS, QK_NOPE + QK_ROPE), Q_LORA ** -0.5),
        'w_dkv': nrm((N_MLA, d, KV_LORA + QK_ROPE), d ** -0.5),
        'g_kv': 1.0 + nrm((N_MLA, KV_LORA), 0.02),
        'w_uk': nrm((N_MLA, KV_LORA, MLA_HEADS, QK_NOPE), KV_LORA ** -0.5),
        'w_uv': nrm((N_MLA, KV_LORA, MLA_HEADS, V_HEAD), KV_LORA ** -0.5),
        'w_mla_o': nrm((N_MLA, MLA_HEADS * V_HEAD, d), BETA * (MLA_HEADS * V_HEAD) ** -0.5),
        'w_lru_in': nrm((N_LRU, d, 2 * D_RNN), d ** -0.5),
        'lru_conv_w': nrm((N_LRU, CONV_W, D_RNN), CONV_W ** -0.5),
        'lru_conv_b': nrm((N_LRU, D_RNN), 0.02),
        'w_lru_a': nrm((N_LRU, 2, LRU_BLOCKS, LRU_BW, LRU_BW), LRU_BW ** -0.5),
        'b_lru_a': nrm((N_LRU, 2, D_RNN), 0.02),
        'w_lru_i': nrm((N_LRU, 2, LRU_BLOCKS, LRU_BW, LRU_BW), LRU_BW ** -0.5),
        'b_lru_i': nrm((N_LRU, 2, D_RNN), 0.02),
        'lru_lambda': jnp.log(a0) - jnp.log1p(-a0),
        'w_lru_out': nrm((N_LRU, D_RNN, d), BETA * D_RNN ** -0.5),
    }


def reference(x_prompt, x_sample, cache_mla_ckv, cache_mla_krope, state_lru, c, c_ctx,
              w_ada, b_ada, ln_g, ln_b, w_ffn_in, w_ffn_out, w_pool, pool_scale,
              w_dq, g_q, w_uq, w_dkv, g_kv, w_uk, w_uv, w_mla_o,
              w_lru_in, lru_conv_w, lru_conv_b, w_lru_a, b_lru_a, w_lru_i, b_lru_i,
              lru_lambda, w_lru_out):
    x = x_prompt
    B0 = x.shape[0]
    ckv_list, krope_list, lru_list = [], [], []
    for i in range(DEPTH):
        sh1, sc1, g1, sh2, sc2, g2 = modulation(c_ctx[None], w_ada[i], b_ada[i])
        h = x * (1.0 + sc1) + sh1
        kind, j = i % N_MIXERS, i // N_MIXERS
        if kind == 0:
            out = pool_mix(h, w_pool[j], pool_scale[j])
        elif kind == 1:
            qn, qr, ckv, kr = mla_project(h, w_dq[j], g_q[j], w_uq[j], w_dkv[j], g_kv[j])
            out = mla_attend(qn, qr, ckv, kr, w_uk[j], w_uv[j], w_mla_o[j])
            ckv_list.append(ckv)
            krope_list.append(kr)
        else:
            h0 = jnp.zeros((B0, D_RNN), jnp.float32)
            out, hf, hb = lru_mixer(h, w_lru_in[j], lru_conv_w[j], lru_conv_b[j], w_lru_a[j], b_lru_a[j],
                                    w_lru_i[j], b_lru_i[j], lru_lambda[j], w_lru_out[j], h0, h0)
            lru_list.append(jnp.stack([hf, hb], axis=1))
        x = layer_norm(ALPHA * x + g1 * out, ln_g[i, 0], ln_b[i, 0])
        h = x * (1.0 + sc2) + sh2
        x = layer_norm(ALPHA * x + g2 * swiglu(h, w_ffn_in[i], w_ffn_out[i]), ln_g[i, 1], ln_b[i, 1])
    y_prompt = x
    new_mla_ckv = jnp.stack(ckv_list, axis=1)
    new_mla_krope = jnp.stack(krope_list, axis=1)
    new_lru_state = jnp.stack(lru_list, axis=1)

    x = x_sample
    T = x.shape[1]
    cos, sin = rope_tables(T)
    for i in range(DEPTH):
        sh1, sc1, g1, sh2, sc2, g2 = modulation(c, w_ada[i], b_ada[i])
        h = x * (1.0 + sc1) + sh1
        kind, j = i % N_MIXERS, i // N_MIXERS
        if kind == 0:
            out = pool_mix(h, w_pool[j], pool_scale[j])
        elif kind == 1:
            qn, qr, ckv, kr = mla_project(h, w_dq[j], g_q[j], w_uq[j], w_dkv[j], g_kv[j])
            qr = apply_rope(qr, cos[:, None], sin[:, None])
            kr = apply_rope(kr, cos, sin)
            ckv_all = jnp.concatenate([cache_mla_ckv[:, j].astype(ckv.dtype), ckv], axis=1)
            kr_all = jnp.concatenate([cache_mla_krope[:, j].astype(kr.dtype), kr], axis=1)
            out = mla_attend(qn, qr, ckv_all, kr_all, w_uk[j], w_uv[j], w_mla_o[j])
        else:
            out, _, _ = lru_mixer(h, w_lru_in[j], lru_conv_w[j], lru_conv_b[j], w_lru_a[j], b_lru_a[j],
                                  w_lru_i[j], b_lru_i[j], lru_lambda[j], w_lru_out[j],
                                  state_lru[:, j, 0], state_lru[:, j, 1])
        x = layer_norm(ALPHA * x + g1 * out, ln_g[i, 0], ln_b[i, 0])
        h = x * (1.0 + sc2) + sh2
        x = layer_norm(ALPHA * x + g2 * swiglu(h, w_ffn_in[i], w_ffn_out[i]), ln_g[i, 1], ln_b[i, 1])
    y_sample = x
    return (y_prompt, y_sample, new_mla_ckv, new_mla_krope, new_lru_state)
```

```cpp
#include <hip/hip_runtime.h>
#include <cstdio>
#include <cstdint>

constexpr int DM = 1024, DFF = 2816, MCTX = 4096, MT = 12288, KROWS = 14336;
constexpr float ALPHA = 1.6817928305074292f, LN_EPS = 1e-6f;
constexpr float MLA_SCALE = 0.07216878364870323f;
constexpr int NPHASE = 32;

constexpr size_t MiB = 1u << 20;
constexpr size_t WS_CTL = 0, CTL_ZERO_BYTES = 1 * MiB;
constexpr size_t WS_MOD = 1 * MiB;
constexpr size_t WS_ROPE = 2 * MiB;
constexpr size_t WS_SP = 2 * MiB + 65536;
constexpr size_t W_FFN_IN = 3 * MiB;
constexpr size_t W_FFN_OUT = W_FFN_IN + 4ull * 5632 * 1024 * 2;
constexpr size_t W_POOL = W_FFN_OUT + 4ull * 1024 * 2816 * 2;
constexpr size_t W_DQKV = W_POOL + 8ull * 256 * 256 * 2;
constexpr size_t W_UQ = W_DQKV + 768ull * 1024 * 2;
constexpr size_t W_UKV = W_UQ + 1536ull * 384 * 2;
constexpr size_t W_O = W_UKV + 2048ull * 256 * 2;
constexpr size_t W_LIN = W_O + 1024ull * 1024 * 2;
constexpr size_t W_GATE = W_LIN + 2048ull * 1024 * 2;
constexpr size_t W_LOUT = W_GATE + 4096ull * 256 * 2;
constexpr size_t W_END = W_LOUT + 1024ull * 1024 * 2;
constexpr size_t WS_H = 84 * MiB;
constexpr size_t WS_VTMP = WS_H + 24 * MiB;
constexpr size_t WS_TMP = WS_VTMP + 48 * MiB;
static_assert(W_END <= WS_H, "weights fit");
constexpr size_t T_ACT = WS_TMP;
constexpr size_t T_RAW = WS_TMP, T_QN = WS_TMP + 36 * MiB, T_CKV = WS_TMP + 45 * MiB, T_KRA = WS_TMP + 52 * MiB, T_Q = WS_TMP + 54 * MiB, T_KN = WS_TMP + 90 * MiB, T_VV = WS_TMP + 118 * MiB;
constexpr size_t T_Y = WS_TMP, T_UCONV = WS_TMP + 24 * MiB, T_AF = WS_TMP + 48 * MiB, T_AB = WS_TMP + 96 * MiB, T_BF = WS_TMP + 144 * MiB, T_BB = WS_TMP + 168 * MiB, T_SUM = WS_TMP + 192 * MiB;
constexpr size_t WS_END = WS_TMP + 200 * MiB;
constexpr size_t O_CKV = 12582912, O_KR = 13631488, O_LRU = 13893632, O_END = 13926400;
constexpr int CW_BAR = 4096;

constexpr int LDS_BYTES = 147456, MISC_OFF = 131072 + 320;

#define LAS __attribute__((address_space(3)))
#define LDS_WAIT() asm volatile("s_waitcnt lgkmcnt(0)" ::: "memory")
#define VM_WAIT() asm volatile("s_waitcnt vmcnt(0)" ::: "memory")
typedef unsigned short bf16;
typedef unsigned v4u __attribute__((ext_vector_type(4)));
typedef unsigned v2u __attribute__((ext_vector_type(2)));
typedef float f32x2 __attribute__((ext_vector_type(2)));
typedef float f32x16 __attribute__((ext_vector_type(16)));
typedef short s16x4 __attribute__((ext_vector_type(4)));
__device__ __forceinline__ unsigned f2bf(float f) { unsigned u = __builtin_bit_cast(unsigned, f); return (u + 0x7fffu + ((u >> 16) & 1u)) >> 16; }
__device__ __forceinline__ unsigned pk2(float lo, float hi) { return f2bf(lo) | (f2bf(hi) << 16); }
__device__ __forceinline__ float bf2f(unsigned b) { return __builtin_bit_cast(float, b << 16); }
__device__ __forceinline__ float shfl_xor_l(float v, int o, int lane) { return __builtin_bit_cast(float, __builtin_amdgcn_ds_bpermute((lane ^ o) << 2, __builtin_bit_cast(int, v))); }
__device__ __forceinline__ float wave_sum(float v, int lane) {
#pragma unroll
    for (int o = 1; o < 64; o <<= 1) v += shfl_xor_l(v, o, lane);
    return v;
}
__device__ __forceinline__ float fsigmoid(float x) { return __builtin_amdgcn_rcpf(1.0f + __expf(-x)); }
__device__ __forceinline__ int lane_id() { int l; asm volatile("v_mbcnt_lo_u32_b32 %0, -1, 0\n\tv_mbcnt_hi_u32_b32 %0, -1, %0" : "=v"(l)); return l; }
__device__ __forceinline__ int cond_of_row(int row) { return row < MCTX ? 0 : 1 + ((row - MCTX) >> 10); }


__device__ __forceinline__ int pg8_lane_id() { int l; asm volatile("v_mbcnt_lo_u32_b32 %0, -1, 0\n\tv_mbcnt_hi_u32_b32 %0, -1, %0" : "=v"(l)); return l; }
namespace pg8 {
#define PG8_LAS __attribute__((address_space(3)))
typedef unsigned short bf16_t;
typedef short bf16x8 __attribute__((ext_vector_type(8)));
typedef float f32x4 __attribute__((ext_vector_type(4)));
typedef unsigned u32x4 __attribute__((ext_vector_type(4)));
constexpr int BM = 256, BK = 64, HALF = 128, HTB = HALF * BK * 2  , STAGE_BYTES = 8 * HTB, NXCD = 8, WGM = 8;

__host__ __device__ __forceinline__ int lds_byte(int r, int c) { const int st = (r >> 4) * 2 + (c >> 5), rr = r & 15, cc = c & 31, ob = rr * 64 + cc * 2; return st * 1024 + (ob ^ (((ob >> 9) & 1) << 5)); }
__host__ __device__ __forceinline__ void stage_rc(int b, int& R, int& C) { const int st = b / 1024, sb = b % 1024, swz = sb ^ (((sb >> 9) & 1) << 5); R = (st >> 1) * 16 + swz / 64; C = (st & 1) * 32 + (swz % 64) / 2; }
__host__ __device__ __forceinline__ int perm32(int rho) { const int n = rho >> 4, i = rho & 15; return 8 * (i >> 2) + 4 * n + (i & 3); }

struct Unit { int pm, pn; };
template <int K_, int LDA_, int ASH_> struct Gemm { static constexpr int K = K_, lda = LDA_, a_shift = ASH_; const bf16_t* A; const bf16_t* Bt; };

struct StaticOrder {
    int nM, nN, nwg, G, c, wave;
    __device__ void init(int M, int N, int G_, int c_, int wave_) { nM = M / BM; nN = N / BM; nwg = nM * nN; G = G_; c = c_; wave = wave_; }
    __device__ bool next(int i, Unit& u) const {
        const long L = (long)i * G + c; if (L >= nwg) return false;
        int wgid = (int)L; { const int q = nwg / NXCD, r = nwg % NXCD, xcd = wgid % NXCD, off = wgid / NXCD; wgid = (xcd < r ? xcd * (q + 1) : r * (q + 1) + (xcd - r) * q) + off; }
        const int nig = WGM * nN, gid = wgid / nig, fm = gid * WGM, gsz = (nM - fm) < WGM ? (nM - fm) : WGM;
        u.pm = __builtin_amdgcn_readfirstlane(fm + ((wgid % nig) % gsz)); u.pn = __builtin_amdgcn_readfirstlane((wgid % nig) / gsz); return true;
    }
    __device__ __forceinline__ void a_ready(const Unit&) const {}
    __device__ __forceinline__ void done(const Unit&) const {}
};

__device__ __forceinline__ unsigned cvt_pk_bf16(float lo, float hi) { unsigned r; asm volatile("v_cvt_pk_bf16_f32 %0, %1, %2" : "=v"(r) : "v"(lo), "v"(hi)); return r; }

template <class Epi, class Sched, bool ALIGN_EPI, bool SP2, class GemmT>
__device__ __forceinline__ void gemm_phase(PG8_LAS unsigned char* lds, const GemmT g, const Sched& S, const Epi& E) {
    int tid_ = S.wave * 64 + pg8_lane_id(); asm volatile("" : "+v"(tid_));
    const int tid = tid_, wid = __builtin_amdgcn_readfirstlane(tid >> 6), lane = tid & 63, wr = wid >> 2, wc = wid & 3, fr = lane & 15, fq = lane >> 4;
    constexpr int K = GemmT::K, nt = K / BK;
    unsigned voffA[2], voffB[2];
#pragma unroll
    for (int i = 0; i < 2; ++i) { int R, C; stage_rc(tid * 16 + i * 8192, R, C); const int Rb = Epi::PERM ? ((R & ~31) + perm32(R & 31)) : R;
        voffA[i] = (unsigned)(R * GemmT::lda + C) * 2u; voffB[i] = (unsigned)(Rb * K + C) * 2u; }
    constexpr size_t kstep = (size_t)(BK * 2);
    constexpr size_t hstepA = (size_t)HALF * GemmT::lda * 2, hstepB = (size_t)HALF * K * 2;
    constexpr size_t tstepA = 2 * hstepA, tstepB = 2 * hstepB;
#define PG8_ACOL(pn) ((size_t)(GemmT::a_shift < 0 ? 0 : (((pn) >> (GemmT::a_shift < 0 ? 0 : GemmT::a_shift)) * 512)))
    const unsigned ldsw = (unsigned)wid * 1024u;
    const int aoff = lds_byte(wr * 64 + fr, fq * 8), boff = lds_byte(wc * 32 + fr, fq * 8);
#define PG8_SA(b, h) (((b) * 2 + (h)) * HTB)
#define PG8_SB(b, h) ((4 + (b) * 2 + (h)) * HTB)
#define PG8_STAGE(bufoff, gbase, voff) do { _Pragma("unroll") for (int _i = 0; _i < 2; ++_i) \
        __builtin_amdgcn_global_load_lds((const unsigned*)((const char*)(gbase) + (voff)[_i]), (PG8_LAS unsigned*)(lds + (bufoff) + ldsw + _i * 8192), 16, 0, 0); } while (0)
#define PG8_LDA(dst, b, h) do { _Pragma("unroll") for (int m = 0; m < 4; ++m) _Pragma("unroll") for (int k = 0; k < 2; ++k) dst[m][k] = *(const PG8_LAS bf16x8*)(lds + PG8_SA(b, h) + aoff + m * 2048 + k * 1024); } while (0)
#define PG8_LDB(dst, b, h) do { _Pragma("unroll") for (int n = 0; n < 2; ++n) _Pragma("unroll") for (int k = 0; k < 2; ++k) dst[n][k] = *(const PG8_LAS bf16x8*)(lds + PG8_SB(b, h) + boff + n * 2048 + k * 1024); } while (0)
#define PG8_MMA(ai, bj, At, Bt) do { __builtin_amdgcn_s_setprio(1); _Pragma("unroll") for (int m = 0; m < 4; ++m) _Pragma("unroll") for (int n = 0; n < 2; ++n) _Pragma("unroll") for (int k = 0; k < 2; ++k) \
        acc[ai][bj][m][n] = __builtin_amdgcn_mfma_f32_16x16x32_bf16(Bt[n][k], At[m][k], acc[ai][bj][m][n], 0, 0, 0); __builtin_amdgcn_s_setprio(0); } while (0)
#define PG8_WAIT_V(n) asm volatile("s_waitcnt vmcnt(" #n ")" ::: "memory")
#define PG8_WAIT_L(n) asm volatile("s_waitcnt lgkmcnt(" #n ")" ::: "memory")
#define PG8_BAR __builtin_amdgcn_s_barrier()
#define PG8_SCHED __builtin_amdgcn_sched_barrier(0)
    Unit cur, nxt; int ui = 0;
    if (!S.next(0, cur)) return;
    f32x4 acc[2][2][4][2];
#pragma unroll
    for (int a = 0; a < 2; ++a)
#pragma unroll
        for (int b = 0; b < 2; ++b)
#pragma unroll
            for (int m = 0; m < 4; ++m)
#pragma unroll
                for (int n = 0; n < 2; ++n) acc[a][b][m][n] = (f32x4){0.f, 0.f, 0.f, 0.f};
    bf16x8 At[4][2], B0[2][2], B1[2][2];
    const char* cA = (const char*)g.A + (size_t)cur.pm * tstepA + PG8_ACOL(cur.pn); const char* cB = (const char*)g.Bt + (size_t)cur.pn * tstepB;
    S.a_ready(cur);
    if constexpr (SP2) {
        PG8_STAGE(PG8_SB(0, 0), cB, voffB); PG8_STAGE(PG8_SB(0, 1), cB + hstepB, voffB); PG8_STAGE(PG8_SA(0, 0), cA, voffA); PG8_STAGE(PG8_SA(0, 1), cA + hstepA, voffA);
        if (wr == 1) PG8_BAR;
        PG8_WAIT_V(2); PG8_BAR;
        PG8_STAGE(PG8_SB(1, 0), cB + kstep, voffB); PG8_STAGE(PG8_SA(1, 0), cA + kstep, voffA); PG8_STAGE(PG8_SB(1, 1), cB + hstepB + kstep, voffB);
        PG8_WAIT_V(6); PG8_BAR;
    } else {
        PG8_STAGE(PG8_SB(0, 0), cB, voffB); PG8_STAGE(PG8_SA(0, 0), cA, voffA); PG8_STAGE(PG8_SB(0, 1), cB + hstepB, voffB); PG8_STAGE(PG8_SA(0, 1), cA + hstepA, voffA);
        if (wr == 1) PG8_BAR;
        PG8_WAIT_V(4); PG8_BAR;
        PG8_STAGE(PG8_SB(1, 0), cB + kstep, voffB); PG8_STAGE(PG8_SA(1, 0), cA + kstep, voffA); PG8_STAGE(PG8_SB(1, 1), cB + hstepB + kstep, voffB);
        PG8_WAIT_V(6); PG8_BAR;
    }
    for (;;) {
        const bool has_next = S.next(ui + 1, nxt);
        const char* nA = has_next ? (const char*)g.A + (size_t)nxt.pm * tstepA + PG8_ACOL(nxt.pn) : cA; const char* nB = has_next ? (const char*)g.Bt + (size_t)nxt.pn * tstepB : cB;
        for (int t = 0; t < nt; t += 2) {
            const bool last = (t == nt - 2);
            const char* a1 = cA + (size_t)(t + 1) * kstep;
            const char* a2 = last ? nA : cA + (size_t)(t + 2) * kstep; const char* b2 = last ? nB : cB + (size_t)(t + 2) * kstep;
            const char* a3 = a2 + kstep; const char* b3 = b2 + kstep;
            if (last && has_next) S.a_ready(nxt);
            if constexpr (SP2) {
            PG8_LDB(B0, 0, 0); PG8_LDB(B1, 0, 1); PG8_SCHED; PG8_LDA(At, 0, 0); PG8_STAGE(PG8_SA(1, 1), a1 + hstepA, voffA);
            PG8_WAIT_V(8); PG8_WAIT_L(0); PG8_BAR; PG8_MMA(0, 0, At, B0); PG8_MMA(0, 1, At, B1); PG8_BAR; PG8_SCHED;
            PG8_LDA(At, 0, 1); PG8_STAGE(PG8_SB(0, 0), b2, voffB); PG8_STAGE(PG8_SB(0, 1), b2 + hstepB, voffB); PG8_STAGE(PG8_SA(0, 0), a2, voffA);
            PG8_WAIT_V(8); PG8_WAIT_L(0); PG8_BAR; PG8_MMA(1, 0, At, B0); PG8_MMA(1, 1, At, B1); PG8_BAR; PG8_SCHED;
            PG8_LDB(B0, 1, 0); PG8_LDB(B1, 1, 1); PG8_SCHED; PG8_LDA(At, 1, 0); PG8_STAGE(PG8_SA(0, 1), a2 + hstepA, voffA);
            PG8_WAIT_V(8); PG8_WAIT_L(0); PG8_BAR; PG8_MMA(0, 0, At, B0); PG8_MMA(0, 1, At, B1); PG8_BAR; PG8_SCHED;
            PG8_LDA(At, 1, 1); PG8_STAGE(PG8_SB(1, 0), b3, voffB); PG8_STAGE(PG8_SB(1, 1), b3 + hstepB, voffB); PG8_STAGE(PG8_SA(1, 0), a3, voffA);
            PG8_WAIT_V(8); PG8_WAIT_L(0); PG8_BAR; PG8_MMA(1, 0, At, B0); PG8_MMA(1, 1, At, B1); PG8_BAR; PG8_SCHED;
            } else {
            PG8_LDB(B0, 0, 0); PG8_SCHED; PG8_LDA(At, 0, 0); PG8_STAGE(PG8_SA(1, 1), a1 + hstepA, voffA);
            PG8_WAIT_L(8); PG8_BAR; PG8_WAIT_L(0); PG8_MMA(0, 0, At, B0); PG8_BAR; PG8_SCHED;
            PG8_LDB(B1, 0, 1); PG8_STAGE(PG8_SB(0, 0), b2, voffB);
            PG8_BAR; PG8_WAIT_L(0); PG8_MMA(0, 1, At, B1); PG8_BAR;
            PG8_LDA(At, 0, 1); PG8_STAGE(PG8_SA(0, 0), a2, voffA);
            PG8_BAR; PG8_WAIT_L(0); PG8_MMA(1, 0, At, B0); PG8_BAR; PG8_SCHED;
            PG8_STAGE(PG8_SB(0, 1), b2 + hstepB, voffB);
            PG8_WAIT_V(6); PG8_BAR; PG8_MMA(1, 1, At, B1); PG8_BAR;
            PG8_LDB(B0, 1, 0); PG8_SCHED; PG8_LDA(At, 1, 0); PG8_STAGE(PG8_SA(0, 1), a2 + hstepA, voffA);
            PG8_WAIT_L(8); PG8_BAR; PG8_WAIT_L(0); PG8_MMA(0, 0, At, B0); PG8_BAR; PG8_SCHED;
            PG8_LDB(B1, 1, 1); PG8_STAGE(PG8_SB(1, 0), b3, voffB);
            PG8_BAR; PG8_WAIT_L(0); PG8_MMA(0, 1, At, B1); PG8_BAR;
            PG8_LDA(At, 1, 1); PG8_STAGE(PG8_SA(1, 0), a3, voffA);
            PG8_BAR; PG8_WAIT_L(0); PG8_MMA(1, 0, At, B0); PG8_BAR; PG8_SCHED;
            PG8_STAGE(PG8_SB(1, 1), b3 + hstepB, voffB);
            PG8_WAIT_V(6); PG8_BAR; PG8_MMA(1, 1, At, B1); PG8_BAR;
            }
        }
        if constexpr (ALIGN_EPI) { if (wr == 0) PG8_BAR; }
        if constexpr (!Epi::AFTER_DRAIN) { int lane_e = pg8_lane_id(); asm volatile("" : "+v"(lane_e)); const int fr_e = lane_e & 15, fq_e = lane_e >> 4;     E(acc, cur, wr, wc, fr_e, fq_e); S.done(cur); }
        if (!has_next) break;
#pragma unroll
        for (int a = 0; a < 2; ++a)
#pragma unroll
            for (int b = 0; b < 2; ++b)
#pragma unroll
                for (int m = 0; m < 4; ++m)
#pragma unroll
                    for (int n = 0; n < 2; ++n) acc[a][b][m][n] = (f32x4){0.f, 0.f, 0.f, 0.f};
        cur = nxt; cA = nA; cB = nB; ++ui;
        if constexpr (ALIGN_EPI) { if (wr == 1) PG8_BAR; }
    }
    PG8_WAIT_V(0);
    if constexpr (!ALIGN_EPI) { if (wr == 0) PG8_BAR; }
    PG8_BAR;
    if constexpr (Epi::AFTER_DRAIN) { E.fused(acc, cur, wr, wc, fr, fq, lds, wid, lane); S.done(cur); }
#undef PG8_ACOL
#undef PG8_SA
#undef PG8_SB
#undef PG8_STAGE
#undef PG8_LDA
#undef PG8_LDB
#undef PG8_MMA
#undef PG8_WAIT_V
#undef PG8_WAIT_L
#undef PG8_BAR
#undef PG8_SCHED
}
}


using namespace pg8;
__device__ __forceinline__ int cond_of_pm(int pm) { return pm < 16 ? 0 : 1 + ((pm - 16) >> 2); }

struct EpiResid {
    static constexpr bool PERM = false, AFTER_DRAIN = false;
    const float* xlo; const float* xhi; float* v; const float* gate; const float* colscale;
    __device__ __forceinline__ void operator()(const f32x4 (&acc)[2][2][4][2], const Unit& u, int wr, int wc, int fr, int fq) const {
        const int ci = cond_of_pm(u.pm), col0 = u.pn * BM + wc * 32 + 4 * fq;
        const float* gp = gate + (size_t)ci * 6144 + col0;
        f32x4 gv[2][2];
#pragma unroll
        for (int bj = 0; bj < 2; ++bj)
#pragma unroll
            for (int n = 0; n < 2; ++n) { gv[bj][n] = *(const f32x4*)(gp + bj * HALF + n * 16); if (colscale) gv[bj][n] = gv[bj][n] * *(const f32x4*)(colscale + col0 + bj * HALF + n * 16); }
#pragma unroll
        for (int ai = 0; ai < 2; ++ai)
#pragma unroll
            for (int m = 0; m < 4; ++m) { const int row = u.pm * BM + ai * HALF + wr * 64 + m * 16 + fr;
                const float* xr = (row < MCTX ? xlo + (size_t)row * DM : xhi + (size_t)(row - MCTX) * DM) + col0; float* vr = v + (size_t)row * DM + col0;
#pragma unroll
                for (int bj = 0; bj < 2; ++bj)
#pragma unroll
                    for (int n = 0; n < 2; ++n) { const f32x4 xv = *(const f32x4*)(xr + bj * HALF + n * 16); *(f32x4*)(vr + bj * HALF + n * 16) = xv * ALPHA + gv[bj][n] * acc[ai][bj][m][n]; }
                if (m & 1) asm volatile("" ::: "memory"); __builtin_amdgcn_sched_barrier(0); }
    }
};

struct EpiSwiGLU {
    static constexpr bool PERM = true, AFTER_DRAIN = false;
    bf16* act;
    __device__ __forceinline__ void operator()(const f32x4 (&acc)[2][2][4][2], const Unit& u, int wr, int wc, int fr, int fq) const {
        const int col0 = u.pn * HALF + wc * 32 + 8 * fq;
#pragma unroll
        for (int ai = 0; ai < 2; ++ai)
#pragma unroll
            for (int m = 0; m < 4; ++m) { const int row = u.pm * BM + ai * HALF + wr * 64 + m * 16 + fr;
                f32x4 r0, r1;
#pragma unroll
                for (int j = 0; j < 4; ++j) { const float a0 = acc[ai][0][m][0][j], a1 = acc[ai][0][m][1][j];
                    r0[j] = a0 * fsigmoid(a0) * acc[ai][1][m][0][j]; r1[j] = a1 * fsigmoid(a1) * acc[ai][1][m][1][j]; }
                u32x4 w; w.x = cvt_pk_bf16(r0[0], r0[1]); w.y = cvt_pk_bf16(r0[2], r0[3]); w.z = cvt_pk_bf16(r1[0], r1[1]); w.w = cvt_pk_bf16(r1[2], r1[3]);
                *(u32x4*)(act + (size_t)row * DFF + col0) = w; }
    }
};

struct EpiF32 {
    static constexpr bool PERM = false, AFTER_DRAIN = false;
    float* C; int ldc;
    __device__ __forceinline__ void operator()(const f32x4 (&acc)[2][2][4][2], const Unit& u, int wr, int wc, int fr, int fq) const {
        const int row0 = u.pm * BM + wr * 64 + fr, col0 = u.pn * BM + wc * 32 + 4 * fq;
#pragma unroll
        for (int ai = 0; ai < 2; ++ai)
#pragma unroll
            for (int m = 0; m < 4; ++m) { float* rowp = C + (size_t)(row0 + ai * HALF + m * 16) * ldc + col0;
#pragma unroll
                for (int bj = 0; bj < 2; ++bj)
#pragma unroll
                    for (int n = 0; n < 2; ++n) *(f32x4*)(rowp + bj * HALF + n * 16) = acc[ai][bj][m][n]; }
    }
};

struct EpiQ {
    static constexpr bool PERM = false, AFTER_DRAIN = false;
    bf16* q; const float* rope;
    __device__ __forceinline__ void operator()(const f32x4 (&acc)[2][2][4][2], const Unit& u, int wr, int wc, int fr, int fq) const {
        const int col0 = u.pn * BM + wc * 32 + 4 * fq;
#pragma unroll
        for (int bj = 0; bj < 2; ++bj) { const int g32 = 8 * u.pn + 4 * bj + wc, gi = g32 % 6;
            const bool rot = (gi >= 4) && (u.pm >= 16);
#pragma unroll
            for (int ai = 0; ai < 2; ++ai)
#pragma unroll
                for (int m = 0; m < 4; ++m) { const int row = u.pm * BM + ai * HALF + wr * 64 + m * 16 + fr;
                    f32x4 x1 = acc[ai][bj][m][0], x2 = acc[ai][bj][m][1];
                    if (rot) { const int t = (row - MCTX) & 1023, pos = (gi == 4) ? (t >> 6) : (t & 63); const float* rp = rope + (pos * 16 + 4 * fq) * 2;
                        const f32x4 cs0 = *(const f32x4*)rp, cs1 = *(const f32x4*)(rp + 4);
                        const f32x4 c = (f32x4){cs0[0], cs0[2], cs1[0], cs1[2]}, s = (f32x4){cs0[1], cs0[3], cs1[1], cs1[3]};
                        const f32x4 o1 = x1 * c - x2 * s, o2 = x2 * c + x1 * s; x1 = o1; x2 = o2; }
                    bf16* qp = q + (size_t)row * 1536 + col0 + bj * HALF;
                    v2u w1, w2; w1.x = cvt_pk_bf16(x1[0], x1[1]); w1.y = cvt_pk_bf16(x1[2], x1[3]); w2.x = cvt_pk_bf16(x2[0], x2[1]); w2.y = cvt_pk_bf16(x2[2], x2[3]);
                    *(v2u*)qp = w1; *(v2u*)(qp + 16) = w2; asm volatile("" ::: "memory"); __builtin_amdgcn_sched_barrier(0); } }
    }
};

struct EpiKV {
    static constexpr bool PERM = true, AFTER_DRAIN = false;
    bf16* kn; bf16* vv;
    __device__ __forceinline__ void operator()(const f32x4 (&acc)[2][2][4][2], const Unit& u, int wr, int wc, int fr, int fq) const {
        bf16* base = (u.pn < 4) ? kn : vv; const int col0 = (u.pn & 3) * BM + wc * 32 + 8 * fq;
#pragma unroll
        for (int ai = 0; ai < 2; ++ai)
#pragma unroll
            for (int m = 0; m < 4; ++m) { const int row = u.pm * BM + ai * HALF + wr * 64 + m * 16 + fr;
#pragma unroll
                for (int bj = 0; bj < 2; ++bj) { const f32x4 v0 = acc[ai][bj][m][0], v1 = acc[ai][bj][m][1];
                    u32x4 w; w.x = cvt_pk_bf16(v0[0], v0[1]); w.y = cvt_pk_bf16(v0[2], v0[3]); w.z = cvt_pk_bf16(v1[0], v1[1]); w.w = cvt_pk_bf16(v1[2], v1[3]);
                    *(u32x4*)(base + (size_t)row * DM + col0 + bj * HALF) = w; } asm volatile("" ::: "memory"); __builtin_amdgcn_sched_barrier(0); }
    }
};

__device__ __forceinline__ float gelu_tanh(float x) { const float z2 = 1.5957691216057308f * (x + 0.044715f * x * x * x); return x * __builtin_amdgcn_rcpf(1.0f + __expf(-z2)); }

struct EpiLruIn {
    static constexpr bool PERM = false, AFTER_DRAIN = false;
    float* uo; bf16* yo;
    __device__ __forceinline__ void operator()(const f32x4 (&acc)[2][2][4][2], const Unit& u, int wr, int wc, int fr, int fq) const {
        const int col0 = (u.pn & 3) * BM + wc * 32 + 4 * fq;
#pragma unroll
        for (int ai = 0; ai < 2; ++ai)
#pragma unroll
            for (int m = 0; m < 4; ++m) { const int row = u.pm * BM + ai * HALF + wr * 64 + m * 16 + fr;
#pragma unroll
                for (int bj = 0; bj < 2; ++bj)
#pragma unroll
                    for (int n = 0; n < 2; ++n) { const f32x4 a = acc[ai][bj][m][n]; const size_t off = (size_t)row * DM + col0 + bj * HALF + n * 16;
                        if (u.pn < 4) *(f32x4*)(uo + off) = a;
                        else { v2u w; w.x = cvt_pk_bf16(gelu_tanh(a[0]), gelu_tanh(a[1])); w.y = cvt_pk_bf16(gelu_tanh(a[2]), gelu_tanh(a[3])); *(v2u*)(yo + off) = w; } } }
    }
};

struct EpiGates {
    static constexpr bool PERM = false, AFTER_DRAIN = false;
    const bf16* uc; const float* b_a; const float* b_i; const float* sp; float* af; float* ab; bf16* bfo; bf16* bbo;
    __device__ __forceinline__ void operator()(const f32x4 (&acc)[2][2][4][2], const Unit& u, int wr, int wc, int fr, int fq) const {
        const int ch0 = 256 * (u.pn >> 2) + 64 * (u.pn & 3) + 16 * wc + 4 * fq;
        const f32x4 baf = *(const f32x4*)(b_a + ch0), bab = *(const f32x4*)(b_a + 1024 + ch0), bif = *(const f32x4*)(b_i + ch0), bib = *(const f32x4*)(b_i + 1024 + ch0);
        const f32x4 spf = *(const f32x4*)(sp + ch0), spb = *(const f32x4*)(sp + 1024 + ch0);
#pragma unroll
        for (int ai = 0; ai < 2; ++ai)
#pragma unroll
            for (int m = 0; m < 4; ++m) { const int row = u.pm * BM + ai * HALF + wr * 64 + m * 16 + fr; const size_t off = (size_t)row * DM + ch0;
                const v2u uw = *(const v2u*)(uc + off); const f32x4 uu = (f32x4){bf2f(uw.x & 0xffffu), bf2f(uw.x >> 16), bf2f(uw.y & 0xffffu), bf2f(uw.y >> 16)};
                f32x4 a_f, a_b, b_f, b_b;
#pragma unroll
                for (int j = 0; j < 4; ++j) {
                    const float rf = fsigmoid(acc[ai][0][m][0][j] + baf[j]), rb = fsigmoid(acc[ai][0][m][1][j] + bab[j]);
                    const float gf = fsigmoid(acc[ai][1][m][0][j] + bif[j]), gb = fsigmoid(acc[ai][1][m][1][j] + bib[j]);
                    const float laf = -8.0f * rf * spf[j], lab = -8.0f * rb * spb[j];
                    a_f[j] = __expf(laf); a_b[j] = __expf(lab);
                    b_f[j] = sqrtf(-expm1f(2.0f * laf)) * (gf * uu[j]); b_b[j] = sqrtf(-expm1f(2.0f * lab)) * (gb * uu[j]); }
                *(f32x4*)(af + off) = a_f; *(f32x4*)(ab + off) = a_b;
                v2u w1, w2; w1.x = cvt_pk_bf16(b_f[0], b_f[1]); w1.y = cvt_pk_bf16(b_f[2], b_f[3]); w2.x = cvt_pk_bf16(b_b[0], b_b[1]); w2.y = cvt_pk_bf16(b_b[2], b_b[3]);
                *(v2u*)(bfo + off) = w1; *(v2u*)(bbo + off) = w2; asm volatile("" ::: "memory"); __builtin_amdgcn_sched_barrier(0); }
    }
};


#define XB_TMO      128
#define XB_XCNT(j)  (256  + 64 * (j))
#define XB_XSUB(j)  (1280 + 64 * (j))
#define XB_XGEN(j)  (2304 + 64 * (j))
#define XB_TOP      3328
#define XB_TOPGEN   3392
#define XCD_BAR_WORDS 3456
#define XB_SPIN_CAP (1u << 18)
__device__ __forceinline__ unsigned xb_ld(unsigned* p)              { return __hip_atomic_load(p, __ATOMIC_RELAXED, __HIP_MEMORY_SCOPE_AGENT); }
__device__ __forceinline__ unsigned xb_add(unsigned* p, unsigned v) { return __hip_atomic_fetch_add(p, v, __ATOMIC_RELAXED, __HIP_MEMORY_SCOPE_AGENT); }
__device__ __forceinline__ unsigned xb_xcc_id() { return (unsigned)__builtin_amdgcn_s_getreg((3 << 11) | 20) & 0xFu; }
#define XB_SPIN(cond, bar) do { unsigned _sp = 0; while (cond) { __builtin_amdgcn_s_sleep(1); \
    if ((++_sp & 255u) == 0u) { if (xb_ld(&(bar)[XB_TMO])) break; if (_sp > XB_SPIN_CAP) { atomicAdd(&(bar)[XB_TMO], 1u); break; } } } } while (0)
struct XcdBarrier { unsigned* bar; unsigned x; volatile LAS unsigned* st; };
__device__ __forceinline__ XcdBarrier xcd_barrier_post(unsigned* bar, volatile LAS unsigned* st, int tid) {
    XcdBarrier b; b.bar = bar; b.x = xb_xcc_id(); b.st = st;
    if (tid == 0) (void)xb_add(&bar[XB_XCNT(b.x)], 1u);
    return b;
}
__device__ __forceinline__ void xcd_barrier_complete(unsigned* bar, unsigned x, unsigned& nloc, unsigned& nx) {
    const unsigned G = gridDim.x * gridDim.y * gridDim.z;
    unsigned sum, cnt, mine, sp = 0u;
    for (;;) {
        sum = 0u; cnt = 0u; mine = 0u;
#pragma unroll
        for (unsigned j = 0; j < 16; ++j) { const unsigned c = xb_ld(&bar[XB_XCNT(j)]); sum += c; cnt += (c > 0u) ? 1u : 0u; mine = (j == x) ? c : mine; }
        if (sum == G) break;
        __builtin_amdgcn_s_sleep(1);
        if ((++sp & 255u) == 0u) { if (xb_ld(&bar[XB_TMO])) break; if (sp > XB_SPIN_CAP) { atomicAdd(&bar[XB_TMO], 1u); break; } }
    }
    nloc = mine > 0u ? mine : 1u; nx = cnt > 0u ? cnt : 1u;
}
__device__ __forceinline__ void xcd_barrier(const XcdBarrier& b, int tid) {
    asm volatile("s_waitcnt vmcnt(0)" ::: "memory");
    __syncthreads();
    if (tid == 0) {
        unsigned* bar = b.bar;
        __builtin_amdgcn_s_waitcnt(0);
        unsigned nloc = b.st[0], nx = b.st[1];
        if (nloc == 0u) { xcd_barrier_complete(bar, b.x, nloc, nx); b.st[0] = nloc; b.st[1] = nx; }
        const unsigned old = xb_add(&bar[XB_XSUB(b.x)], 1u);
        const unsigned gen = old / nloc;
        if (old + 1u == (gen + 1u) * nloc) {
            __builtin_amdgcn_fence(__ATOMIC_RELEASE, "agent");
            asm volatile("s_waitcnt vmcnt(0)" ::: "memory");
            const unsigned og = xb_add(&bar[XB_TOP], 1u);
            const unsigned tg = og / nx;
            if (og + 1u == (tg + 1u) * nx) xb_add(&bar[XB_TOPGEN], 1u);
            else XB_SPIN(xb_ld(&bar[XB_TOPGEN]) == tg, bar);
            __builtin_amdgcn_fence(__ATOMIC_ACQUIRE, "agent");
            xb_add(&bar[XB_XGEN(b.x)], 1u);
            asm volatile("s_waitcnt vmcnt(0)" ::: "memory");
        } else {
            XB_SPIN(xb_ld(&bar[XB_XGEN(b.x)]) == gen, bar);
            __builtin_amdgcn_fence(__ATOMIC_ACQUIRE, "agent");
            asm volatile("s_waitcnt vmcnt(0)" ::: "memory");
        }
    }
    __syncthreads();
}

struct Args { const float* in[32]; float* out; unsigned char* ws; int ph_lo, ph_hi; };
enum { I_XP = 0, I_XS, I_CCKV, I_CKR, I_STATE, I_C, I_CCTX, I_WADA, I_BADA, I_LNG, I_LNB, I_WFIN, I_WFOUT, I_WPOOL, I_PSCALE, I_WDQ, I_GQ, I_WUQ, I_WDKV, I_GKV, I_WUK, I_WUV, I_WO,
       I_WLIN, I_CONVW, I_CONVB, I_WLA, I_BLA, I_WLI, I_BLI, I_LAM, I_WLOUT };
struct Ctx {
    LAS unsigned char* lds; int tid, lane, wave, G, gw, NGW, gt, NT;
    const float* const* in; float* out; unsigned char* ws;
};
__device__ __forceinline__ const float* mod_layer(const Ctx& F, int l) { return (const float*)(F.ws + WS_MOD) + (size_t)l * 9 * 6144; }

struct RmOff { int off; __device__ __forceinline__ int operator()(int n) const { return n + off; } };
struct RmSwi { __device__ __forceinline__ int operator()(int n) const { return n < DFF ? 256 * (n >> 7) + (n & 127) : 256 * ((n - DFF) >> 7) + 128 + ((n - DFF) & 127); } };
template <class RM>
__device__ __forceinline__ void p0_transpose_item(const float* W, int ldw, int K, bf16* WT, LAS float* scr, int item, int lane, RM rm) {
    const int nblk = ldw / 32, kb = item / nblk, nb = item % nblk, k0 = 64 * kb, n0 = 32 * nb;
#pragma unroll 8
    for (int i = 0; i < 32; ++i) { const int kk = 2 * i + (lane >> 5); scr[kk * 33 + (lane & 31)] = W[(size_t)(k0 + kk) * ldw + n0 + (lane & 31)]; }
    LDS_WAIT(); asm volatile("" ::: "memory");
    const int c = lane & 7;
#pragma unroll
    for (int j = 0; j < 4; ++j) { const int n = (lane >> 3) + 8 * j; const LAS float* s = scr + (8 * c) * 33 + n;
        v4u o; o.x = pk2(s[0 * 33], s[1 * 33]); o.y = pk2(s[2 * 33], s[3 * 33]); o.z = pk2(s[4 * 33], s[5 * 33]); o.w = pk2(s[6 * 33], s[7 * 33]);
        *(v4u*)(WT + (size_t)rm(n0 + n) * K + k0 + 8 * c) = o; }
    LDS_WAIT(); asm volatile("" ::: "memory");
}

__device__ __forceinline__ void p0_prologue(Ctx& F) {
    const float* const* in = F.in; unsigned char* ws = F.ws;
    {
        LAS float* S = (LAS float*)F.lds;
        LAS float* P = (LAS float*)(F.lds + 36864);
        if ((int)blockIdx.x < 192) {
            for (int i = F.tid; i < 9 * 1024; i += 512) { const int ci = i >> 10, k = i & 1023; const float c = ci == 0 ? in[I_CCTX][k] : in[I_C][(ci - 1) * 1024 + k]; S[i] = c * fsigmoid(c); }
            __syncthreads();
            for (int item = blockIdx.x; item < 192; item += F.G) {
                const int l = item / 48, n0 = (item % 48) * 128, cg = F.tid & 31, kg = F.tid >> 5;
                const float* wp = in[I_WADA] + ((size_t)l * 1024 + kg * 64) * 6144 + n0 + 4 * cg;
                f32x4 acc[9];
#pragma unroll
                for (int ci = 0; ci < 9; ++ci) acc[ci] = (f32x4){0.f, 0.f, 0.f, 0.f};
#pragma unroll 4
                for (int kk = 0; kk < 64; ++kk) { const f32x4 w = *(const f32x4*)(wp + (size_t)kk * 6144);
#pragma unroll
                    for (int ci = 0; ci < 9; ++ci) acc[ci] += w * S[ci * 1024 + kg * 64 + kk]; }
#pragma unroll
                for (int ci = 0; ci < 9; ++ci) *(LAS f32x4*)(P + (kg * 9 + ci) * 128 + 4 * cg) = acc[ci];
                __syncthreads();
                for (int o = F.tid; o < 9 * 128; o += 512) { const int ci = o >> 7, c = o & 127; float s = in[I_BADA][l * 6144 + n0 + c];
#pragma unroll
                    for (int g = 0; g < 16; ++g) s += P[(g * 9 + ci) * 128 + c];
                    ((float*)(ws + WS_MOD))[((size_t)l * 9 + ci) * 6144 + n0 + c] = s; }
                __syncthreads();
            }
        }
        __syncthreads();
    }
    {
        LAS float* scr = (LAS float*)(F.lds + F.wave * 8448);
        constexpr int C0 = 4 * 16 * 176, C1 = C0 + 4 * 44 * 32, C2 = C1 + 8 * 32, C3 = C2 + 16 * 12, C4 = C3 + 16 * 10, C5 = C4 + 6 * 48, C6 = C5 + 4 * 32, C7 = C6 + 4 * 32, C8 = C7 + 16 * 32, C9 = C8 + 16 * 64, C10 = C9 + 16 * 32;
        for (int it = F.gw; it < C10; it += F.NGW) {
            if (it < C0) { const int l = it / 2816, r = it % 2816; p0_transpose_item(in[I_WFIN] + (size_t)l * 1024 * 5632, 5632, 1024, (bf16*)(ws + W_FFN_IN) + (size_t)l * 5632 * 1024, scr, r, F.lane, RmSwi{}); }
            else if (it < C1) { const int q = it - C0, l = q / 1408, r = q % 1408; p0_transpose_item(in[I_WFOUT] + (size_t)l * DFF * 1024, 1024, DFF, (bf16*)(ws + W_FFN_OUT) + (size_t)l * 1024 * DFF, scr, r, F.lane, RmOff{0}); }
            else if (it < C2) { const int q = it - C1, mi = q / 32, r = q % 32; p0_transpose_item(in[I_WPOOL] + (size_t)mi * 65536, 256, 256, (bf16*)(ws + W_POOL) + (size_t)mi * 65536, scr, r, F.lane, RmOff{0}); }
            else if (it < C3) p0_transpose_item(in[I_WDQ], 384, 1024, (bf16*)(ws + W_DQKV), scr, it - C2, F.lane, RmOff{0});
            else if (it < C4) p0_transpose_item(in[I_WDKV], 320, 1024, (bf16*)(ws + W_DQKV), scr, it - C3, F.lane, RmOff{384});
            else if (it < C5) p0_transpose_item(in[I_WUQ], 1536, 384, (bf16*)(ws + W_UQ), scr, it - C4, F.lane, RmOff{0});
            else if (it < C6) p0_transpose_item(in[I_WUK], 1024, 256, (bf16*)(ws + W_UKV), scr, it - C5, F.lane, RmOff{0});
            else if (it < C7) p0_transpose_item(in[I_WUV], 1024, 256, (bf16*)(ws + W_UKV), scr, it - C6, F.lane, RmOff{1024});
            else if (it < C8) p0_transpose_item(in[I_WO], 1024, 1024, (bf16*)(ws + W_O), scr, it - C7, F.lane, RmOff{0});
            else if (it < C9) p0_transpose_item(in[I_WLIN], 2048, 1024, (bf16*)(ws + W_LIN), scr, it - C8, F.lane, RmOff{0});
            else p0_transpose_item(in[I_WLOUT], 1024, 1024, (bf16*)(ws + W_LOUT), scr, it - C9, F.lane, RmOff{0});
        }
    }
    for (int it = F.gt; it < 4096 * 32; it += F.NT) {
        const int R = it >> 5, kc = it & 31, pn = R >> 8, cc = R & 255, jp = pn >> 2, q = pn & 3;
        const int bj = cc >> 7, wc = (cc >> 5) & 3, n = (cc >> 4) & 1, e = cc & 15, d = n, isI = bj, nb = 2 * jp + (q >> 1), mch = 64 * (q & 1) + 16 * wc + e;
        v4u o = (v4u){0u, 0u, 0u, 0u};
        if ((kc >> 4) == (q >> 1)) { const float* W = (isI ? in[I_WLI] : in[I_WLA]) + ((size_t)(d * 8 + nb) * 128 + (kc & 15) * 8) * 128 + mch;
            o.x = pk2(W[0], W[128]); o.y = pk2(W[256], W[384]); o.z = pk2(W[512], W[640]); o.w = pk2(W[768], W[896]); }
        *(v4u*)((bf16*)(ws + W_GATE) + (size_t)R * 256 + kc * 8) = o;
    }
    for (int it = F.gt; it < 1024; it += F.NT) { const int pos = it >> 4, f = it & 15; const double inv = exp(-(double)f / 16.0 * 9.210340371976184  ); const float ang = (float)pos * (float)inv;
        float s, c; sincosf(ang, &s, &c); ((float*)(ws + WS_ROPE))[2 * it] = c; ((float*)(ws + WS_ROPE))[2 * it + 1] = s; }
    for (int it = F.gt; it < 2048; it += F.NT) ((float*)(ws + WS_SP))[it] = (float)log1p(exp(-(double)in[I_LAM][it]));
    for (int it = F.gt; it < 64 * 1024 / 8; it += F.NT) *(v4u*)((bf16*)(ws + W_DQKV) + (size_t)704 * 1024 + it * 8) = (v4u){0u, 0u, 0u, 0u};
}

__device__ __forceinline__ void ln_phase(Ctx& F, const float* v, float* xo, bf16* ho, const float* g, const float* b, const float* modl, int w_sh, int w_sc) {
    for (int row = F.gw; row < MT; row += F.NGW) {
        const f32x4* vr = (const f32x4*)(v + (size_t)row * DM) + F.lane;
        f32x4 x[4]; float s = 0.f;
#pragma unroll
        for (int j = 0; j < 4; ++j) { x[j] = vr[64 * j]; s += (x[j][0] + x[j][1]) + (x[j][2] + x[j][3]); }
        const float mean = wave_sum(s, F.lane) * (1.f / DM); float s2 = 0.f;
#pragma unroll
        for (int j = 0; j < 4; ++j) { x[j] = x[j] - mean; s2 += (x[j][0] * x[j][0] + x[j][1] * x[j][1]) + (x[j][2] * x[j][2] + x[j][3] * x[j][3]); }
        const float rstd = 1.f / sqrtf(wave_sum(s2, F.lane) * (1.f / DM) + LN_EPS);
        const int ci = cond_of_row(row);
#pragma unroll
        for (int j = 0; j < 4; ++j) { const int col = 4 * F.lane + 256 * j;
            const f32x4 y = x[j] * rstd * *(const f32x4*)(g + col) + *(const f32x4*)(b + col);
            *(f32x4*)(xo + (size_t)row * DM + col) = y;
            if (ho) { const f32x4 sc = *(const f32x4*)(modl + (size_t)ci * 6144 + w_sc * 1024 + col), sh = *(const f32x4*)(modl + (size_t)ci * 6144 + w_sh * 1024 + col);
                const f32x4 h = y * (1.0f + sc) + sh; v2u w; w.x = cvt_pk_bf16(h[0], h[1]); w.y = cvt_pk_bf16(h[2], h[3]); *(v2u*)(ho + (size_t)row * DM + col) = w; } }
    }
}

__device__ __forceinline__ void pool_ew_phase(Ctx& F, const float* xlo, const float* xhi, const float* modl, bf16* po) {
    for (int it = F.gt; it < 384 * 256; it += F.NT) {
        const int tc = it >> 8, c4 = it & 255, col = 4 * c4, half = 1 << (c4 >> 6), row0 = tc * 32;
        const int T = row0 < MCTX ? 256 : 1024, s0 = row0 < MCTX ? (row0 & ~255) : MCTX + ((row0 - MCTX) & ~1023), t0 = row0 - s0;
        const float* xb = (row0 < MCTX ? xlo + (size_t)s0 * DM : xhi + (size_t)(s0 - MCTX) * DM) + col;
        const f32x4 sc1 = 1.0f + *(const f32x4*)(modl + (size_t)cond_of_row(row0) * 6144 + 1 * 1024 + col);
        f32x4 sum = (f32x4){0.f, 0.f, 0.f, 0.f};
        { const int lo = t0 - half > 0 ? t0 - half : 0, hi = t0 + half < T ? t0 + half : T; for (int s = lo; s < hi; ++s) sum += *(const f32x4*)(xb + (size_t)s * DM); }
        for (int i = 0; i < 32; ++i) { const int t = t0 + i, lo = t - half > 0 ? t - half : 0, hi = t + half < T ? t + half : T;
            const f32x4 xc = *(const f32x4*)(xb + (size_t)t * DM); const f32x4 p = (sum * (1.0f / (float)(hi - lo)) - xc) * sc1;
            v2u w; w.x = cvt_pk_bf16(p[0], p[1]); w.y = cvt_pk_bf16(p[2], p[3]); *(v2u*)(po + (size_t)(s0 + t) * DM + col) = w;
            if (t + half < T) sum += *(const f32x4*)(xb + (size_t)(t + half) * DM);
            if (t - half >= 0) sum -= *(const f32x4*)(xb + (size_t)(t - half) * DM); }
    }
}

__device__ __forceinline__ int keyrow_of(int row) { return row < MCTX ? row : MCTX + ((row - MCTX) >> 10) * 1280 + 256 + ((row - MCTX) & 1023); }
__device__ __forceinline__ void mla_post_phase(Ctx& F) {
    const float* raw = (const float*)(F.ws + T_RAW); bf16* qn = (bf16*)(F.ws + T_QN); bf16* ckv = (bf16*)(F.ws + T_CKV); bf16* kra = (bf16*)(F.ws + T_KRA);
    const float* rope = (const float*)(F.ws + WS_ROPE); const float* g_q = F.in[I_GQ]; const float* g_kv = F.in[I_GKV]; const int lane = F.lane;
    for (int row = F.gw; row < MT; row += F.NGW) {
        const float* r = raw + (size_t)row * 768;
        f32x2 q[3]; float s = 0.f;
#pragma unroll
        for (int j = 0; j < 3; ++j) { q[j] = *(const f32x2*)(r + 2 * lane + 128 * j); s += q[j][0] * q[j][0] + q[j][1] * q[j][1]; }
        const float rq = 1.f / sqrtf(wave_sum(s, lane) * (1.f / 384.f) + LN_EPS);
#pragma unroll
        for (int j = 0; j < 3; ++j) { const int col = 2 * lane + 128 * j; const f32x2 gq = *(const f32x2*)(g_q + col); *(unsigned*)(qn + (size_t)row * 384 + col) = cvt_pk_bf16(q[j][0] * rq * gq[0], q[j][1] * rq * gq[1]); }
        const f32x4 c = *(const f32x4*)(r + 384 + 4 * lane); const float sc = (c[0] * c[0] + c[1] * c[1]) + (c[2] * c[2] + c[3] * c[3]);
        const float rc = 1.f / sqrtf(wave_sum(sc, lane) * (1.f / 256.f) + LN_EPS);
        const f32x4 cn = c * rc * *(const f32x4*)(g_kv + 4 * lane);
        const int kr_row = keyrow_of(row);
        { v2u w; w.x = cvt_pk_bf16(cn[0], cn[1]); w.y = cvt_pk_bf16(cn[2], cn[3]); *(v2u*)(ckv + (size_t)kr_row * 256 + 4 * lane) = w; }
        float k = r[640 + lane];
        if (row < MCTX) { *(f32x4*)(F.out + O_CKV + (size_t)row * 256 + 4 * lane) = cn; F.out[O_KR + (size_t)row * 64 + lane] = k; }
        const float partner = shfl_xor_l(k, 16, lane);
        if (row >= MCTX) { const int t = (row - MCTX) & 1023, pos = (lane < 32) ? (t >> 6) : (t & 63), f = lane & 15; const float cc = rope[(pos * 16 + f) * 2], ss = rope[(pos * 16 + f) * 2 + 1];
            k = (lane & 16) ? (k * cc + partner * ss) : (k * cc - partner * ss); }
        kra[(size_t)kr_row * 64 + lane] = (bf16)f2bf(k);
    }
    for (int r2 = F.gw; r2 < 2048; r2 += F.NGW) {
        const int b = r2 >> 8, s = r2 & 255, kr_row = MCTX + b * 1280 + s;
        const f32x4 c = *(const f32x4*)(F.in[I_CCKV] + (size_t)r2 * 256 + 4 * lane);
        v2u w; w.x = cvt_pk_bf16(c[0], c[1]); w.y = cvt_pk_bf16(c[2], c[3]); *(v2u*)(ckv + (size_t)kr_row * 256 + 4 * lane) = w;
        kra[(size_t)kr_row * 64 + lane] = (bf16)f2bf(F.in[I_CKR][(size_t)r2 * 64 + lane]);
    }
}

__device__ __forceinline__ void lru_conv_phase(Ctx& F) {
    const float* u = (const float*)(F.ws + WS_VTMP); bf16* uc = (bf16*)(F.ws + T_UCONV); const float* cw = F.in[I_CONVW]; const float* cb = F.in[I_CONVB];
    for (int it = F.gt; it < 384 * 256; it += F.NT) {
        const int tc = it >> 8, col = 4 * (it & 255), row0 = tc * 32;
        const int T = row0 < MCTX ? 256 : 1024, s0 = row0 < MCTX ? (row0 & ~255) : MCTX + ((row0 - MCTX) & ~1023), t0 = row0 - s0;
        const float* ub = u + (size_t)s0 * DM + col;
        const f32x4 w0 = *(const f32x4*)(cw + col), w1 = *(const f32x4*)(cw + 1024 + col), w2 = *(const f32x4*)(cw + 2048 + col), w3 = *(const f32x4*)(cw + 3072 + col), bb = *(const f32x4*)(cb + col);
        const f32x4 z = (f32x4){0.f, 0.f, 0.f, 0.f};
        f32x4 um = t0 > 0 ? *(const f32x4*)(ub + (size_t)(t0 - 1) * DM) : z, u0 = *(const f32x4*)(ub + (size_t)t0 * DM), u1 = t0 + 1 < T ? *(const f32x4*)(ub + (size_t)(t0 + 1) * DM) : z;
        for (int i = 0; i < 32; ++i) { const int t = t0 + i; const f32x4 u2 = t + 2 < T ? *(const f32x4*)(ub + (size_t)(t + 2) * DM) : z;
            const f32x4 o = um * w0 + u0 * w1 + u1 * w2 + u2 * w3 + bb;
            v2u w; w.x = cvt_pk_bf16(o[0], o[1]); w.y = cvt_pk_bf16(o[2], o[3]); *(v2u*)(uc + (size_t)(s0 + t) * DM + col) = w;
            um = u0; u0 = u1; u1 = u2; }
    }
}

__device__ __forceinline__ void lru_scan1_phase(Ctx& F) {
    const float* af = (const float*)(F.ws + T_AF); const float* ab = (const float*)(F.ws + T_AB); const bf16* bfp = (const bf16*)(F.ws + T_BF); const bf16* bbp = (const bf16*)(F.ws + T_BB);
    float* sum = (float*)(F.ws + T_SUM);
    for (int it = F.gt; it < 384 * 512; it += F.NT) {
        const int c32 = it >> 9, ch = 2 * (it & 511); const size_t base = (size_t)c32 * 32 * DM + ch;
        f32x2 A = (f32x2){1.f, 1.f}, B = (f32x2){0.f, 0.f};
#pragma unroll 8
        for (int i = 0; i < 32; ++i) { const f32x2 a = *(const f32x2*)(af + base + (size_t)i * DM); const unsigned bw = *(const unsigned*)(bfp + base + (size_t)i * DM);
            B = a * B + (f32x2){bf2f(bw & 0xffffu), bf2f(bw >> 16)}; A = A * a; }
        *(f32x2*)(sum + ((size_t)0 * 384 + c32) * DM + ch) = A; *(f32x2*)(sum + ((size_t)1 * 384 + c32) * DM + ch) = B;
        A = (f32x2){1.f, 1.f}; B = (f32x2){0.f, 0.f};
#pragma unroll 8
        for (int i = 31; i >= 0; --i) { const f32x2 a = *(const f32x2*)(ab + base + (size_t)i * DM); const unsigned bw = *(const unsigned*)(bbp + base + (size_t)i * DM);
            B = a * B + (f32x2){bf2f(bw & 0xffffu), bf2f(bw >> 16)}; A = A * a; }
        *(f32x2*)(sum + ((size_t)2 * 384 + c32) * DM + ch) = A; *(f32x2*)(sum + ((size_t)3 * 384 + c32) * DM + ch) = B;
    }
}
__device__ __forceinline__ void lru_scan2_phase(Ctx& F) {
    const float* af = (const float*)(F.ws + T_AF); const float* ab = (const float*)(F.ws + T_AB); const bf16* bfp = (const bf16*)(F.ws + T_BF); const bf16* bbp = (const bf16*)(F.ws + T_BB);
    const float* sum = (const float*)(F.ws + T_SUM); const bf16* y = (const bf16*)(F.ws + T_Y); bf16* hs = (bf16*)(F.ws + WS_H);
    for (int it = F.gt; it < 384 * 512; it += F.NT) {
        const int c32 = it >> 9, ch = 2 * (it & 511), row0 = c32 * 32; const size_t base = (size_t)row0 * DM + ch;
        const bool ctx = row0 < MCTX; const int nc = ctx ? 8 : 32, cs = ctx ? (c32 & ~7) : 128 + ((c32 - 128) & ~31);
        f32x2 hf = (f32x2){0.f, 0.f}, hb = (f32x2){0.f, 0.f};
        if (!ctx) { const int b = (row0 - MCTX) >> 10; hf = *(const f32x2*)(F.in[I_STATE] + (size_t)(b * 2 + 0) * DM + ch); hb = *(const f32x2*)(F.in[I_STATE] + (size_t)(b * 2 + 1) * DM + ch); }
        for (int c = cs; c < c32; ++c) hf = *(const f32x2*)(sum + ((size_t)0 * 384 + c) * DM + ch) * hf + *(const f32x2*)(sum + ((size_t)1 * 384 + c) * DM + ch);
        for (int c = cs + nc - 1; c > c32; --c) hb = *(const f32x2*)(sum + ((size_t)2 * 384 + c) * DM + ch) * hb + *(const f32x2*)(sum + ((size_t)3 * 384 + c) * DM + ch);
        f32x2 hfv[32];
#pragma unroll
        for (int i = 0; i < 32; ++i) { const f32x2 a = *(const f32x2*)(af + base + (size_t)i * DM); const unsigned bw = *(const unsigned*)(bfp + base + (size_t)i * DM);
            hf = a * hf + (f32x2){bf2f(bw & 0xffffu), bf2f(bw >> 16)}; hfv[i] = hf; }
#pragma unroll
        for (int i = 31; i >= 0; --i) { const f32x2 a = *(const f32x2*)(ab + base + (size_t)i * DM); const unsigned bw = *(const unsigned*)(bbp + base + (size_t)i * DM);
            hb = a * hb + (f32x2){bf2f(bw & 0xffffu), bf2f(bw >> 16)};
            const unsigned yw = *(const unsigned*)(y + base + (size_t)i * DM);
            *(unsigned*)(hs + base + (size_t)i * DM) = cvt_pk_bf16((hfv[i][0] + hb[0]) * bf2f(yw & 0xffffu), (hfv[i][1] + hb[1]) * bf2f(yw >> 16)); }
        if (ctx) { const int b = row0 >> 8;
            if (c32 == cs + nc - 1) *(f32x2*)(F.out + O_LRU + (size_t)(b * 2 + 0) * DM + ch) = hf;
            if (c32 == cs) *(f32x2*)(F.out + O_LRU + (size_t)(b * 2 + 1) * DM + ch) = hb; }
    }
}


namespace att {
constexpr int QBLK = 32, KVBLK = 64;
constexpr int SHM_V = KVBLK * 128 * 2, SHM_K = KVBLK * 128 * 2, SHM_R = KVBLK * 64 * 2;
constexpr int OFF_V = 0, OFF_K = 2 * SHM_V, OFF_R = OFF_K + 2 * SHM_K, OFF_WS = OFF_R + 2 * SHM_R, LDS_TOTAL = OFF_WS + 8 * 256;
constexpr int LDQ = 1536, LDK = 1024, LDR = 64, LDO = 1024;
constexpr float THR = 8.f;
#define KSWZ(row, colB) ((row) * 256 + ((colB) ^ (((row) & 7) << 4)))
#define RSWZ(row, colB) ((row) * 128 + ((colB) ^ (((row) & 7) << 4)))
#define SBAR() __builtin_amdgcn_sched_barrier(0)
__device__ __forceinline__ int crow(int r, int hi) { return (r & 3) + 8 * (r >> 2) + 4 * hi; }
__device__ __forceinline__ unsigned cvtpk(float lo, float hi) { unsigned r; asm volatile("v_cvt_pk_bf16_f32 %0, %1, %2" : "=v"(r) : "v"(lo), "v"(hi)); return r; }
__device__ __forceinline__ void partialSM(f32x16& p0, f32x16& p1, float& m_reg, float& mn, float& alpha) {
  constexpr float C = MLA_SCALE * 1.4426950408889634f;
  float pmax = p0[0];
#pragma unroll
  for (int r = 1; r < 16; ++r) pmax = fmaxf(pmax, p0[r]);
#pragma unroll
  for (int r = 0; r < 16; ++r) pmax = fmaxf(pmax, p1[r]);
  { auto rr = __builtin_amdgcn_permlane32_swap(__float_as_uint(pmax), __float_as_uint(pmax), false, false);
    pmax = fmaxf(__uint_as_float(rr[0]), __uint_as_float(rr[1])); }
  if (__builtin_expect(__all(pmax - m_reg <= THR / MLA_SCALE), 1)) { mn = m_reg; alpha = 1.f; }
  else { mn = fmaxf(m_reg, pmax); alpha = __builtin_amdgcn_exp2f((m_reg - mn) * C); m_reg = mn; }
  float mnC = -mn * C;
#pragma unroll
  for (int r = 0; r < 16; ++r) p0[r] = fmaf(p0[r], C, mnC);
#pragma unroll
  for (int r = 0; r < 16; ++r) p1[r] = fmaf(p1[r], C, mnC);
#pragma unroll
  for (int r = 0; r < 16; ++r) p0[r] = __builtin_amdgcn_exp2f(p0[r]);
}
__device__ __forceinline__ void finishSM(f32x16& p0, f32x16& p1, float alpha, float& l_reg, bf16x8& pa0, bf16x8& pa1, bf16x8& pa2, bf16x8& pa3) {
#pragma unroll
  for (int r = 0; r < 16; ++r) p1[r] = __builtin_amdgcn_exp2f(p1[r]);
  float ps = 0;
#pragma unroll
  for (int r = 0; r < 16; ++r) ps += p0[r];
#pragma unroll
  for (int r = 0; r < 16; ++r) ps += p1[r];
  { auto rr = __builtin_amdgcn_permlane32_swap(__float_as_uint(ps), __float_as_uint(ps), false, false);
    ps = __uint_as_float(rr[0]) + __uint_as_float(rr[1]); }
  l_reg = l_reg * alpha + ps;
#define PK4(P, BASE, OUT) do { unsigned a0 = cvtpk(P[BASE + 0], P[BASE + 1]), a1 = cvtpk(P[BASE + 2], P[BASE + 3]);   \
    unsigned b0 = cvtpk(P[BASE + 4], P[BASE + 5]), b1 = cvtpk(P[BASE + 6], P[BASE + 7]);                              \
    auto r0 = __builtin_amdgcn_permlane32_swap(a0, b0, false, false); auto r1 = __builtin_amdgcn_permlane32_swap(a1, b1, false, false); \
    u32x4 w = {r0[0], r1[0], r0[1], r1[1]}; OUT = __builtin_bit_cast(bf16x8, w); } while (0)
  PK4(p0, 0, pa0); PK4(p0, 8, pa1); PK4(p1, 0, pa2); PK4(p1, 8, pa3);
#undef PK4
}
__device__ __forceinline__ void qkt(f32x16& p0, f32x16& p1, LAS const unsigned char* Ks, LAS const unsigned char* Rs, const bf16x8* qr, int r32, int hi) {
  p0 = f32x16{}; p1 = f32x16{};
#pragma unroll
  for (int d0 = 0; d0 < 8; ++d0) { const int cb = (d0 * 16 + hi * 8) * 2;
    const bf16x8 b0 = *(LAS const bf16x8*)(Ks + KSWZ(r32, cb)), b1 = *(LAS const bf16x8*)(Ks + KSWZ(32 + r32, cb));
    p0 = __builtin_amdgcn_mfma_f32_32x32x16_bf16(b0, qr[d0], p0, 0, 0, 0);
    p1 = __builtin_amdgcn_mfma_f32_32x32x16_bf16(b1, qr[d0], p1, 0, 0, 0); }
#pragma unroll
  for (int d0 = 0; d0 < 4; ++d0) { const int cb = (d0 * 16 + hi * 8) * 2;
    const bf16x8 b0 = *(LAS const bf16x8*)(Rs + RSWZ(r32, cb)), b1 = *(LAS const bf16x8*)(Rs + RSWZ(32 + r32, cb));
    p0 = __builtin_amdgcn_mfma_f32_32x32x16_bf16(b0, qr[8 + d0], p0, 0, 0, 0);
    p1 = __builtin_amdgcn_mfma_f32_32x32x16_bf16(b1, qr[8 + d0], p1, 0, 0, 0); }
}
__device__ __forceinline__ int v_st(int k, int c) { const int kk = (k & ~0xC) | ((k & 4) << 1) | ((k & 8) >> 1); return ((kk >> 3) * 4 + (c >> 5)) * 512 + ((kk & 7) * 32 + (c & 31)) * 2; }
__device__ __forceinline__ int v_rd_base(int lane) { return ((lane & 3) << 3) | (((lane >> 2) & 3) << 6) | (((lane >> 4) & 1) << 5) | (((lane >> 5) & 1) << 8); }
constexpr int v_rd_off(int d0, int ks, int half) { return d0 * 512 + ks * 4096 + half * 2048; }
template <int OFF> __device__ __forceinline__ s16x4 tr_read(int vb) {
  s16x4 r; asm volatile("ds_read_b64_tr_b16 %0, %1 offset:%2" : "=&v"(r) : "v"(vb), "i"(OFF) : "memory"); return r;
}
template <int D0> __device__ __forceinline__ void pv_one(f32x16& od, int vb, bf16x8 pa0, bf16x8 pa1, bf16x8 pa2, bf16x8 pa3) {
  const s16x4 l0 = tr_read<v_rd_off(D0, 0, 0)>(vb), h0 = tr_read<v_rd_off(D0, 0, 1)>(vb), l1 = tr_read<v_rd_off(D0, 1, 0)>(vb), h1 = tr_read<v_rd_off(D0, 1, 1)>(vb);
  const s16x4 l2 = tr_read<v_rd_off(D0, 2, 0)>(vb), h2 = tr_read<v_rd_off(D0, 2, 1)>(vb), l3 = tr_read<v_rd_off(D0, 3, 0)>(vb), h3 = tr_read<v_rd_off(D0, 3, 1)>(vb);
  asm volatile("s_waitcnt lgkmcnt(0)" ::: "memory"); SBAR();
#define PK(L, H) (bf16x8){L[0], L[1], L[2], L[3], H[0], H[1], H[2], H[3]}
  od = __builtin_amdgcn_mfma_f32_32x32x16_bf16(pa0, PK(l0, h0), od, 0, 0, 0);
  od = __builtin_amdgcn_mfma_f32_32x32x16_bf16(pa1, PK(l1, h1), od, 0, 0, 0);
  od = __builtin_amdgcn_mfma_f32_32x32x16_bf16(pa2, PK(l2, h2), od, 0, 0, 0);
  od = __builtin_amdgcn_mfma_f32_32x32x16_bf16(pa3, PK(l3, h3), od, 0, 0, 0);
#undef PK
}
__device__ __forceinline__ void pv_d0(f32x16* o, int vb, bf16x8 pa0, bf16x8 pa1, bf16x8 pa2, bf16x8 pa3) {
  pv_one<0>(o[0], vb, pa0, pa1, pa2, pa3); pv_one<1>(o[1], vb, pa0, pa1, pa2, pa3); pv_one<2>(o[2], vb, pa0, pa1, pa2, pa3); pv_one<3>(o[3], vb, pa0, pa1, pa2, pa3);
}
__device__ __forceinline__ void attn_unit(const bf16* __restrict__ Qb, const bf16* __restrict__ Kh, const bf16* __restrict__ Rh, const bf16* __restrict__ Vh, bf16* __restrict__ Ob, int seq, LAS unsigned char* lds, int wave) {
  int tid_ = wave * 64 + lane_id(); asm volatile("" : "+v"(tid_));
  const int tid = tid_, wid = tid >> 6, lane = tid & 63, r32 = lane & 31, hi = lane >> 5;
  LAS unsigned char* V_lds = lds + OFF_V; LAS unsigned char* K_lds = lds + OFF_K; LAS unsigned char* R_lds = lds + OFF_R;
  LAS float* wsf = (LAS float*)(lds + OFF_WS) + wid * 64; LAS float* li_l = wsf; LAS float* al_l = wsf + 32;
  float m_reg = -1e30f, l_reg = 0; f32x16 o[4] = {}; bf16x8 qr[12];
  const bf16* Qw = Qb + (long)(wid * QBLK + r32) * LDQ + hi * 8;
#pragma unroll
  for (int d0 = 0; d0 < 12; ++d0) qr[d0] = *(const bf16x8*)(Qw + d0 * 16);
  const int sr = tid >> 4, sc = (tid & 15) * 8, vst0 = v_st(sr, sc), vst1 = v_st(32 + sr, sc), rr = tid >> 3, rc = (tid & 7) * 8;
  const int vb0 = (int)(unsigned)(uintptr_t)V_lds + v_rd_base(lane);
  bf16x8 vs0, vs1, ks0, ks1, rs0;
#define SLOAD(k0) do { vs0 = *(const bf16x8*)&Vh[(long)((k0) + sr) * LDK + sc]; vs1 = *(const bf16x8*)&Vh[(long)((k0) + 32 + sr) * LDK + sc]; \
    ks0 = *(const bf16x8*)&Kh[(long)((k0) + sr) * LDK + sc]; ks1 = *(const bf16x8*)&Kh[(long)((k0) + 32 + sr) * LDK + sc]; rs0 = *(const bf16x8*)&Rh[(long)((k0) + rr) * LDR + rc]; } while (0)
#define SWRITE(b) do { *(LAS bf16x8*)(V_lds + (b) * SHM_V + vst0) = vs0; *(LAS bf16x8*)(V_lds + (b) * SHM_V + vst1) = vs1; \
    *(LAS bf16x8*)(K_lds + (b) * SHM_K + KSWZ(sr, sc * 2)) = ks0; *(LAS bf16x8*)(K_lds + (b) * SHM_K + KSWZ(32 + sr, sc * 2)) = ks1; \
    *(LAS bf16x8*)(R_lds + (b) * SHM_R + RSWZ(rr, rc * 2)) = rs0; } while (0)
#define SWAIT() asm volatile("s_waitcnt vmcnt(0)" ::: "memory")
#define RESC(a) do { if (__any((a) < 1.f)) { if (hi == 0) al_l[r32] = (a); asm volatile("s_waitcnt lgkmcnt(0)" ::: "memory"); \
    _Pragma("unroll") for (int d = 0; d < 4; ++d) _Pragma("unroll") for (int r = 0; r < 16; ++r) o[d][r] *= al_l[crow(r, hi)]; } } while (0)
  f32x16 pA0, pA1, pB0, pB1; float mnA, mnB, alA, alB; bf16x8 pa0, pa1, pa2, pa3; const int NT = seq / KVBLK;
  SLOAD(0); SWAIT(); SWRITE(0); __syncthreads();
  qkt(pA0, pA1, K_lds, R_lds, qr, r32, hi); partialSM(pA0, pA1, m_reg, mnA, alA);
  SLOAD(KVBLK);
  SWAIT(); SWRITE(1); __syncthreads();
  for (int j = 1; j + 1 < NT; j += 2) {
    SBAR(); qkt(pB0, pB1, K_lds + SHM_K, R_lds + SHM_R, qr, r32, hi);
    finishSM(pA0, pA1, alA, l_reg, pa0, pa1, pa2, pa3); SBAR();
    SLOAD((j + 1) * KVBLK); SBAR();
    pv_d0(o, vb0, pa0, pa1, pa2, pa3); partialSM(pB0, pB1, m_reg, mnB, alB);
    __syncthreads(); SWAIT(); SWRITE(0);
    RESC(alB); __syncthreads();
    SBAR(); qkt(pA0, pA1, K_lds, R_lds, qr, r32, hi);
    finishSM(pB0, pB1, alB, l_reg, pa0, pa1, pa2, pa3); SBAR();
    SLOAD((j + 2) * KVBLK); SBAR();
    pv_d0(o, vb0 + SHM_V, pa0, pa1, pa2, pa3); partialSM(pA0, pA1, m_reg, mnA, alA);
    __syncthreads(); SWAIT(); SWRITE(1);
    RESC(alA); __syncthreads();
  }
  SBAR(); qkt(pB0, pB1, K_lds + SHM_K, R_lds + SHM_R, qr, r32, hi);
  finishSM(pA0, pA1, alA, l_reg, pa0, pa1, pa2, pa3); SBAR();
  pv_d0(o, vb0, pa0, pa1, pa2, pa3); partialSM(pB0, pB1, m_reg, mnB, alB);
  __syncthreads(); RESC(alB);
  finishSM(pB0, pB1, alB, l_reg, pa0, pa1, pa2, pa3); SBAR();
  pv_d0(o, vb0 + SHM_V, pa0, pa1, pa2, pa3);
  if (hi == 0) li_l[r32] = l_reg; asm volatile("s_waitcnt lgkmcnt(0)" ::: "memory");
  float rli[16];
#pragma unroll
  for (int r = 0; r < 16; ++r) rli[r] = __builtin_amdgcn_rcpf(li_l[crow(r, hi)]);
  bf16* Ow = Ob + (long)(wid * QBLK) * LDO;
#pragma unroll
  for (int r = 0; r < 16; ++r) { const int orow = crow(r, hi);
#pragma unroll
    for (int d0 = 0; d0 < 4; ++d0) Ow[(long)orow * LDO + d0 * 32 + r32] = (bf16)f2bf(o[d0][r] * rli[r]); }
  __syncthreads();
#undef SLOAD
#undef SWRITE
#undef SWAIT
#undef RESC
}
}

__device__ __forceinline__ void attn_phase(Ctx& F) {
    const bf16* q = (const bf16*)(F.ws + T_Q); const bf16* kn = (const bf16*)(F.ws + T_KN); const bf16* kra = (const bf16*)(F.ws + T_KRA); const bf16* vv = (const bf16*)(F.ws + T_VV); bf16* o = (bf16*)(F.ws + WS_H);
    for (int un = blockIdx.x; un < 384; un += F.G) {
        int qrow0, krow0, h, seq;
        if (un < 256) { const int b = un >> 5, qb = (un >> 3) & 3; h = un & 7; qrow0 = MCTX + b * 1024 + qb * 256; krow0 = MCTX + b * 1280; seq = 1280; }
        else { const int v = un - 256, b = v >> 3; h = v & 7; qrow0 = b * 256; krow0 = b * 256; seq = 256; }
        att::attn_unit(q + (size_t)qrow0 * 1536 + h * 192, kn + (size_t)krow0 * 1024 + h * 128, kra + (size_t)krow0 * 64, vv + (size_t)krow0 * 1024 + h * 128, o + (size_t)qrow0 * 1024 + h * 128, seq, F.lds, F.wave);
    }
}

__global__ void __launch_bounds__(512, 2) mk_fwd(Args args) {
    extern __shared__ __attribute__((aligned(16))) unsigned char lds_raw[];
    Ctx F;
    F.lds = (LAS unsigned char*)lds_raw; F.wave = __builtin_amdgcn_readfirstlane((int)threadIdx.x >> 6); F.lane = 0; F.tid = 0; F.G = gridDim.x;
    F.gw = blockIdx.x * 8 + F.wave; F.NGW = F.G * 8; F.gt = 0; F.NT = F.G * 512;
    F.in = args.in; F.out = args.out; F.ws = args.ws;
    volatile LAS unsigned* MISC = (volatile LAS unsigned*)(F.lds + MISC_OFF);
    { const int t0 = F.wave * 64 + lane_id(); if (t0 < 32) MISC[t0] = 0u; }
    __syncthreads();
    const int lo = args.ph_lo, hi = args.ph_hi;
    XcdBarrier bar; bar.bar = (unsigned*)(F.ws + WS_CTL) + CW_BAR; bar.x = 0; bar.st = MISC + 8;
    if (hi - lo > 1) bar = xcd_barrier_post((unsigned*)(F.ws + WS_CTL) + CW_BAR, MISC + 8, F.wave * 64 + lane_id());
    int ph = 0, l_ = 0;
#ifndef MK_SP2
#define MK_SP2 true
#endif
#ifndef MK_MASK
#define MK_MASK 0xffffffffu
#endif
#define RUN(id, ...) do { if (lo <= ph && ph < hi) { if constexpr (((MK_MASK) >> (id)) & 1u) { { int t_ = F.wave * 64 + lane_id(), z_ = 0; asm volatile("" : "+v"(t_), "+s"(z_)); F.tid = t_; F.lane = t_ & 63; F.gt = blockIdx.x * 512 + t_; F.in = args.in + z_; unsigned long long pw_ = (unsigned long long)args.ws, po_ = (unsigned long long)args.out; asm volatile("" : "+s"(pw_), "+s"(po_)); F.ws = (unsigned char*)pw_; F.out = (float*)po_; } \
        unsigned char* ws = F.ws; const float* const* in = F.in; bf16* H = (bf16*)(ws + WS_H); float* VT = (float*)(ws + WS_VTMP); float* X = F.out; const float* modl = mod_layer(F, l_); \
        const float* xlo = (l_ == 0) ? in[I_XP] : X; const float* xhi = (l_ == 0) ? in[I_XS] : X + (size_t)MCTX * DM; (void)H; (void)VT; (void)modl; (void)xlo; (void)xhi; __VA_ARGS__; } if (ph + 1 < hi) xcd_barrier(bar, F.wave * 64 + lane_id()); } ++ph; } while (0)
#define GEMM(EpiT, E, Aptr, Bptr, M_, N_, K_, lda_, ash_) do { Gemm<K_, lda_, ash_> g{(const bf16_t*)(Aptr), (const bf16_t*)(Bptr)}; StaticOrder S; S.init(M_, N_, F.G, (int)blockIdx.x, F.wave); \
        gemm_phase<EpiT, StaticOrder, true, MK_SP2, Gemm<K_, lda_, ash_>>(F.lds, g, S, E); } while (0)

    RUN(0, p0_prologue(F));
    for (int l = 0; l < 4; ++l) {
        l_ = l;
        const int kind = l % 3;
        if (kind == 0) {
            const int j = l / 3;
            RUN(1, pool_ew_phase(F, xlo, xhi, modl, H));
            RUN(2, { EpiResid E{xlo, xhi, VT, modl + 2 * 1024, in[I_PSCALE] + j * 1024}; GEMM(EpiResid, E, H, (bf16*)(ws + W_POOL) + (size_t)j * 4 * 65536, MT, 1024, 256, 1024, 0); });
        } else if (kind == 1) {
            RUN(3, { EpiF32 E{(float*)(ws + T_RAW), 768}; GEMM(EpiF32, E, H, ws + W_DQKV, MT, 768, 1024, 1024, -1); });
            RUN(4, mla_post_phase(F));
            RUN(5, { { EpiQ E{(bf16*)(ws + T_Q), (const float*)(ws + WS_ROPE)}; GEMM(EpiQ, E, ws + T_QN, ws + W_UQ, MT, 1536, 384, 384, -1); }
                  { EpiKV E{(bf16*)(ws + T_KN), (bf16*)(ws + T_VV)}; GEMM(EpiKV, E, ws + T_CKV, ws + W_UKV, KROWS, 2048, 256, 256, -1); } });
            RUN(6, attn_phase(F));
            RUN(7, { EpiResid E{xlo, xhi, VT, modl + 2 * 1024, nullptr}; GEMM(EpiResid, E, H, ws + W_O, MT, 1024, 1024, 1024, -1); });
        } else {
            RUN(8, { EpiLruIn E{VT, (bf16*)(ws + T_Y)}; GEMM(EpiLruIn, E, H, ws + W_LIN, MT, 2048, 1024, 1024, -1); });
            RUN(9, lru_conv_phase(F));
            RUN(10, { EpiGates E{(const bf16*)(ws + T_UCONV), in[I_BLA], in[I_BLI], (const float*)(ws + WS_SP), (float*)(ws + T_AF), (float*)(ws + T_AB), (bf16*)(ws + T_BF), (bf16*)(ws + T_BB)};
                  GEMM(EpiGates, E, ws + T_UCONV, ws + W_GATE, MT, 4096, 256, 1024, 2); });
            RUN(11, lru_scan1_phase(F));
            RUN(12, lru_scan2_phase(F));
            RUN(13, { EpiResid E{xlo, xhi, VT, modl + 2 * 1024, nullptr}; GEMM(EpiResid, E, H, ws + W_LOUT, MT, 1024, 1024, 1024, -1); });
        }
        RUN(14, ln_phase(F, VT, X, H, in[I_LNG] + (l * 2 + 0) * 1024, in[I_LNB] + (l * 2 + 0) * 1024, modl, 3, 4));
        RUN(15, { EpiSwiGLU E{(bf16*)(ws + T_ACT)}; GEMM(EpiSwiGLU, E, H, (bf16*)(ws + W_FFN_IN) + (size_t)l * 5632 * 1024, MT, 5632, 1024, 1024, -1); });
        RUN(16, { EpiResid E{X, X + (size_t)MCTX * DM, VT, modl + 5 * 1024, nullptr}; GEMM(EpiResid, E, ws + T_ACT, (bf16*)(ws + W_FFN_OUT) + (size_t)l * 1024 * DFF, MT, 1024, DFF, DFF, -1); });
        RUN(17, { const float* modn = mod_layer(F, l < 3 ? l + 1 : 3); bf16* hn = (l < 3 && (l + 1) % 3 != 0) ? H : nullptr;
                  ln_phase(F, VT, X, hn, in[I_LNG] + (l * 2 + 1) * 1024, in[I_LNB] + (l * 2 + 1) * 1024, modn, 0, 1); });
    }
#undef RUN
#undef GEMM
}

extern "C" void kernel_launch(void* const* d_in, const int* in_sizes, int n_in, void* d_out, int out_size, void* d_ws, size_t ws_size, hipStream_t stream) {
    static int grid = 0;
    if (grid == 0) {
        if (n_in != 32 || out_size != (int)O_END || ws_size < WS_END) { fprintf(stderr, "kernel_launch: unexpected problem: n_in %d out %d ws %zu (need >= %zu)\n", n_in, out_size, ws_size, (size_t)WS_END); grid = -1; return; }
        int dev = 0, cus = 0, per_cu = 0;
        if (hipGetDevice(&dev) != hipSuccess || hipDeviceGetAttribute(&cus, hipDeviceAttributeMultiprocessorCount, dev) != hipSuccess) { grid = -1; return; }
        if (hipFuncSetAttribute((const void*)mk_fwd, hipFuncAttributeMaxDynamicSharedMemorySize, LDS_BYTES) != hipSuccess) { fprintf(stderr, "kernel_launch: hipFuncSetAttribute failed\n"); grid = -1; return; }
        if (hipOccupancyMaxActiveBlocksPerMultiprocessor(&per_cu, (const void*)mk_fwd, 512, LDS_BYTES) != hipSuccess || per_cu < 1) { fprintf(stderr, "kernel_launch: occupancy query says %d\n", per_cu); per_cu = 1; }
        (void)hipGetLastError();
        grid = cus;
    }
    if (grid < 0) return;
    (void)hipMemsetAsync((char*)d_ws + WS_CTL, 0, CTL_ZERO_BYTES, stream);
    Args a{};
    for (int i = 0; i < 32; ++i) a.in[i] = (const float*)d_in[i];
    a.out = (float*)d_out; a.ws = (unsigned char*)d_ws;
#ifndef MK_ONE_LAUNCH
#define MK_ONE_LAUNCH 0
#endif
    if (MK_ONE_LAUNCH) { a.ph_lo = 0; a.ph_hi = NPHASE; hipLaunchKernelGGL(mk_fwd, dim3(grid), dim3(512), LDS_BYTES, stream, a); }
    else for (int p = 0; p < NPHASE; ++p) { a.ph_lo = p; a.ph_hi = p + 1; hipLaunchKernelGGL(mk_fwd, dim3(grid), dim3(512), LDS_BYTES, stream, a); }
}
```

```cpp
#include <hip/hip_runtime.h>
#include <cstdio>
#include <cstdint>

constexpr int DM = 1024, DFF = 2816, MCTX = 4096, MT = 12288, KROWS = 14336;
constexpr float ALPHA = 1.6817928305074292f, LN_EPS = 1e-6f;
constexpr float MLA_SCALE = 0.07216878364870323f;
constexpr int NPHASE = 32;

constexpr size_t MiB = 1u << 20;
constexpr size_t WS_CTL = 0, CTL_ZERO_BYTES = 1 * MiB;
constexpr size_t WS_MOD = 1 * MiB;
constexpr size_t WS_ROPE = 2 * MiB;
constexpr size_t WS_SP = 2 * MiB + 65536;
constexpr size_t W_FFN_IN = 3 * MiB;
constexpr size_t W_FFN_OUT = W_FFN_IN + 4ull * 5632 * 1024 * 2;
constexpr size_t W_POOL = W_FFN_OUT + 4ull * 1024 * 2816 * 2;
constexpr size_t W_DQKV = W_POOL + 8ull * 256 * 256 * 2;
constexpr size_t W_UQ = W_DQKV + 768ull * 1024 * 2;
constexpr size_t W_UKV = W_UQ + 1536ull * 384 * 2;
constexpr size_t W_O = W_UKV + 2048ull * 256 * 2;
constexpr size_t W_LIN = W_O + 1024ull * 1024 * 2;
constexpr size_t W_GATE = W_LIN + 2048ull * 1024 * 2;
constexpr size_t W_LOUT = W_GATE + 4096ull * 256 * 2;
constexpr size_t W_END = W_LOUT + 1024ull * 1024 * 2;
constexpr size_t WS_H = 84 * MiB;
constexpr size_t WS_VTMP = WS_H + 24 * MiB;
constexpr size_t WS_TMP = WS_VTMP + 48 * MiB;
static_assert(W_END <= WS_H, "weights fit");
constexpr size_t T_ACT = WS_TMP;
constexpr size_t T_RAW = WS_TMP, T_QN = WS_TMP + 36 * MiB, T_CKV = WS_TMP + 45 * MiB, T_KRA = WS_TMP + 52 * MiB, T_Q = WS_TMP + 54 * MiB, T_KN = WS_TMP + 90 * MiB, T_VV = WS_TMP + 118 * MiB;
constexpr size_t T_Y = WS_TMP, T_UCONV = WS_TMP + 24 * MiB, T_AF = WS_TMP + 48 * MiB, T_AB = WS_TMP + 96 * MiB, T_BF = WS_TMP + 144 * MiB, T_BB = WS_TMP + 168 * MiB, T_SUM = WS_TMP + 192 * MiB;
constexpr size_t WS_END = WS_TMP + 200 * MiB;
constexpr size_t O_CKV = 12582912, O_KR = 13631488, O_LRU = 13893632, O_END = 13926400;
constexpr int CW_BAR = 4096;

constexpr int LDS_BYTES = 147456, MISC_OFF = 131072 + 320;

#define LAS __attribute__((address_space(3)))
#define LDS_WAIT() asm volatile("s_waitcnt lgkmcnt(0)" ::: "memory")
#define VM_WAIT() asm volatile("s_waitcnt vmcnt(0)" ::: "memory")
typedef unsigned short bf16;
typedef unsigned v4u __attribute__((ext_vector_type(4)));
typedef unsigned v2u __attribute__((ext_vector_type(2)));
typedef float f32x2 __attribute__((ext_vector_type(2)));
typedef float f32x16 __attribute__((ext_vector_type(16)));
typedef short s16x4 __attribute__((ext_vector_type(4)));
__device__ __forceinline__ unsigned f2bf(float f) { unsigned u = __builtin_bit_cast(unsigned, f); return (u + 0x7fffu + ((u >> 16) & 1u)) >> 16; }
__device__ __forceinline__ unsigned pk2(float lo, float hi) { return f2bf(lo) | (f2bf(hi) << 16); }
__device__ __forceinline__ float bf2f(unsigned b) { return __builtin_bit_cast(float, b << 16); }
__device__ __forceinline__ float shfl_xor_l(float v, int o, int lane) { return __builtin_bit_cast(float, __builtin_amdgcn_ds_bpermute((lane ^ o) << 2, __builtin_bit_cast(int, v))); }
__device__ __forceinline__ float wave_sum(float v, int lane) {
#pragma unroll
    for (int o = 1; o < 64; o <<= 1) v += shfl_xor_l(v, o, lane);
    return v;
}
__device__ __forceinline__ float fsigmoid(float x) { return __builtin_amdgcn_rcpf(1.0f + __expf(-x)); }
__device__ __forceinline__ int lane_id() { int l; asm volatile("v_mbcnt_lo_u32_b32 %0, -1, 0\n\tv_mbcnt_hi_u32_b32 %0, -1, %0" : "=v"(l)); return l; }
__device__ __forceinline__ int cond_of_row(int row) { return row < MCTX ? 0 : 1 + ((row - MCTX) >> 10); }


__device__ __forceinline__ int pg8_lane_id() { int l; asm volatile("v_mbcnt_lo_u32_b32 %0, -1, 0\n\tv_mbcnt_hi_u32_b32 %0, -1, %0" : "=v"(l)); return l; }
namespace pg8 {
#define PG8_LAS __attribute__((address_space(3)))
typedef unsigned short bf16_t;
typedef short bf16x8 __attribute__((ext_vector_type(8)));
typedef float f32x4 __attribute__((ext_vector_type(4)));
typedef unsigned u32x4 __attribute__((ext_vector_type(4)));
constexpr int BM = 256, BK = 64, HALF = 128, HTB = HALF * BK * 2  , STAGE_BYTES = 8 * HTB, NXCD = 8, WGM = 8;

__host__ __device__ __forceinline__ int lds_byte(int r, int c) { const int st = (r >> 4) * 2 + (c >> 5), rr = r & 15, cc = c & 31, ob = rr * 64 + cc * 2; return st * 1024 + (ob ^ (((ob >> 9) & 1) << 5)); }
__host__ __device__ __forceinline__ void stage_rc(int b, int& R, int& C) { const int st = b / 1024, sb = b % 1024, swz = sb ^ (((sb >> 9) & 1) << 5); R = (st >> 1) * 16 + swz / 64; C = (st & 1) * 32 + (swz % 64) / 2; }
__host__ __device__ __forceinline__ int perm32(int rho) { const int n = rho >> 4, i = rho & 15; return 8 * (i >> 2) + 4 * n + (i & 3); }

struct Unit { int pm, pn; };
template <int K_, int LDA_, int ASH_> struct Gemm { static constexpr int K = K_, lda = LDA_, a_shift = ASH_; const bf16_t* A; const bf16_t* Bt; };

struct StaticOrder {
    int nM, nN, nwg, G, c, wave;
    __device__ void init(int M, int N, int G_, int c_, int wave_) { nM = M / BM; nN = N / BM; nwg = nM * nN; G = G_; c = c_; wave = wave_; }
    __device__ bool next(int i, Unit& u) const {
        const long L = (long)i * G + c; if (L >= nwg) return false;
        int wgid = (int)L; { const int q = nwg / NXCD, r = nwg % NXCD, xcd = wgid % NXCD, off = wgid / NXCD; wgid = (xcd < r ? xcd * (q + 1) : r * (q + 1) + (xcd - r) * q) + off; }
        const int nig = WGM * nN, gid = wgid / nig, fm = gid * WGM, gsz = (nM - fm) < WGM ? (nM - fm) : WGM;
        u.pm = __builtin_amdgcn_readfirstlane(fm + ((wgid % nig) % gsz)); u.pn = __builtin_amdgcn_readfirstlane((wgid % nig) / gsz); return true;
    }
    __device__ __forceinline__ void a_ready(const Unit&) const {}
    __device__ __forceinline__ void done(const Unit&) const {}
};

__device__ __forceinline__ unsigned cvt_pk_bf16(float lo, float hi) { unsigned r; asm volatile("v_cvt_pk_bf16_f32 %0, %1, %2" : "=v"(r) : "v"(lo), "v"(hi)); return r; }

template <class Epi, class Sched, bool ALIGN_EPI, bool SP2, class GemmT>
__device__ __forceinline__ void gemm_phase(PG8_LAS unsigned char* lds, const GemmT g, const Sched& S, const Epi& E) {
    int tid_ = S.wave * 64 + pg8_lane_id(); asm volatile("" : "+v"(tid_));
    const int tid = tid_, wid = __builtin_amdgcn_readfirstlane(tid >> 6), lane = tid & 63, wr = wid >> 2, wc = wid & 3, fr = lane & 15, fq = lane >> 4;
    constexpr int K = GemmT::K, nt = K / BK;
    unsigned voffA[2], voffB[2];
#pragma unroll
    for (int i = 0; i < 2; ++i) { int R, C; stage_rc(tid * 16 + i * 8192, R, C); const int Rb = Epi::PERM ? ((R & ~31) + perm32(R & 31)) : R;
        voffA[i] = (unsigned)(R * GemmT::lda + C) * 2u; voffB[i] = (unsigned)(Rb * K + C) * 2u; }
    constexpr size_t kstep = (size_t)(BK * 2);
    constexpr size_t hstepA = (size_t)HALF * GemmT::lda * 2, hstepB = (size_t)HALF * K * 2;
    constexpr size_t tstepA = 2 * hstepA, tstepB = 2 * hstepB;
#define PG8_ACOL(pn) ((size_t)(GemmT::a_shift < 0 ? 0 : (((pn) >> (GemmT::a_shift < 0 ? 0 : GemmT::a_shift)) * 512)))
    const unsigned ldsw = (unsigned)wid * 1024u;
    const int aoff = lds_byte(wr * 64 + fr, fq * 8), boff = lds_byte(wc * 32 + fr, fq * 8);
#define PG8_SA(b, h) (((b) * 2 + (h)) * HTB)
#define PG8_SB(b, h) ((4 + (b) * 2 + (h)) * HTB)
#define PG8_STAGE(bufoff, gbase, voff) do { _Pragma("unroll") for (int _i = 0; _i < 2; ++_i) \
        __builtin_amdgcn_global_load_lds((const unsigned*)((const char*)(gbase) + (voff)[_i]), (PG8_LAS unsigned*)(lds + (bufoff) + ldsw + _i * 8192), 16, 0, 0); } while (0)
#define PG8_LDA(dst, b, h) do { _Pragma("unroll") for (int m = 0; m < 4; ++m) _Pragma("unroll") for (int k = 0; k < 2; ++k) dst[m][k] = *(const PG8_LAS bf16x8*)(lds + PG8_SA(b, h) + aoff + m * 2048 + k * 1024); } while (0)
#define PG8_LDB(dst, b, h) do { _Pragma("unroll") for (int n = 0; n < 2; ++n) _Pragma("unroll") for (int k = 0; k < 2; ++k) dst[n][k] = *(const PG8_LAS bf16x8*)(lds + PG8_SB(b, h) + boff + n * 2048 + k * 1024); } while (0)
#define PG8_MMA(ai, bj, At, Bt) do { __builtin_amdgcn_s_setprio(1); _Pragma("unroll") for (int m = 0; m < 4; ++m) _Pragma("unroll") for (int n = 0; n < 2; ++n) _Pragma("unroll") for (int k = 0; k < 2; ++k) \
        acc[ai][bj][m][n] = __builtin_amdgcn_mfma_f32_16x16x32_bf16(Bt[n][k], At[m][k], acc[ai][bj][m][n], 0, 0, 0); __builtin_amdgcn_s_setprio(0); } while (0)
#define PG8_WAIT_V(n) asm volatile("s_waitcnt vmcnt(" #n ")" ::: "memory")
#define PG8_WAIT_L(n) asm volatile("s_waitcnt lgkmcnt(" #n ")" ::: "memory")
#define PG8_BAR __builtin_amdgcn_s_barrier()
#define PG8_SCHED __builtin_amdgcn_sched_barrier(0)
    Unit cur, nxt; int ui = 0;
    if (!S.next(0, cur)) return;
    f32x4 acc[2][2][4][2];
#pragma unroll
    for (int a = 0; a < 2; ++a)
#pragma unroll
        for (int b = 0; b < 2; ++b)
#pragma unroll
            for (int m = 0; m < 4; ++m)
#pragma unroll
                for (int n = 0; n < 2; ++n) acc[a][b][m][n] = (f32x4){0.f, 0.f, 0.f, 0.f};
    bf16x8 At[4][2], B0[2][2], B1[2][2];
    const char* cA = (const char*)g.A + (size_t)cur.pm * tstepA + PG8_ACOL(cur.pn); const char* cB = (const char*)g.Bt + (size_t)cur.pn * tstepB;
    S.a_ready(cur);
    if constexpr (SP2) {
        PG8_STAGE(PG8_SB(0, 0), cB, voffB); PG8_STAGE(PG8_SB(0, 1), cB + hstepB, voffB); PG8_STAGE(PG8_SA(0, 0), cA, voffA); PG8_STAGE(PG8_SA(0, 1), cA + hstepA, voffA);
        if (wr == 1) PG8_BAR;
        PG8_WAIT_V(2); PG8_BAR;
        PG8_STAGE(PG8_SB(1, 0), cB + kstep, voffB); PG8_STAGE(PG8_SA(1, 0), cA + kstep, voffA); PG8_STAGE(PG8_SB(1, 1), cB + hstepB + kstep, voffB);
        PG8_WAIT_V(6); PG8_BAR;
    } else {
        PG8_STAGE(PG8_SB(0, 0), cB, voffB); PG8_STAGE(PG8_SA(0, 0), cA, voffA); PG8_STAGE(PG8_SB(0, 1), cB + hstepB, voffB); PG8_STAGE(PG8_SA(0, 1), cA + hstepA, voffA);
        if (wr == 1) PG8_BAR;
        PG8_WAIT_V(4); PG8_BAR;
        PG8_STAGE(PG8_SB(1, 0), cB + kstep, voffB); PG8_STAGE(PG8_SA(1, 0), cA + kstep, voffA); PG8_STAGE(PG8_SB(1, 1), cB + hstepB + kstep, voffB);
        PG8_WAIT_V(6); PG8_BAR;
    }
    for (;;) {
        const bool has_next = S.next(ui + 1, nxt);
        const char* nA = has_next ? (const char*)g.A + (size_t)nxt.pm * tstepA + PG8_ACOL(nxt.pn) : cA; const char* nB = has_next ? (const char*)g.Bt + (size_t)nxt.pn * tstepB : cB;
        for (int t = 0; t < nt; t += 2) {
            const bool last = (t == nt - 2);
            const char* a1 = cA + (size_t)(t + 1) * kstep;
            const char* a2 = last ? nA : cA + (size_t)(t + 2) * kstep; const char* b2 = last ? nB : cB + (size_t)(t + 2) * kstep;
            const char* a3 = a2 + kstep; const char* b3 = b2 + kstep;
            if (last && has_next) S.a_ready(nxt);
            if constexpr (SP2) {
            PG8_LDB(B0, 0, 0); PG8_LDB(B1, 0, 1); PG8_SCHED; PG8_LDA(At, 0, 0); PG8_STAGE(PG8_SA(1, 1), a1 + hstepA, voffA);
            PG8_WAIT_V(8); PG8_WAIT_L(0); PG8_BAR; PG8_MMA(0, 0, At, B0); PG8_MMA(0, 1, At, B1); PG8_BAR; PG8_SCHED;
            PG8_LDA(At, 0, 1); PG8_STAGE(PG8_SB(0, 0), b2, voffB); PG8_STAGE(PG8_SB(0, 1), b2 + hstepB, voffB); PG8_STAGE(PG8_SA(0, 0), a2, voffA);
            PG8_WAIT_V(8); PG8_WAIT_L(0); PG8_BAR; PG8_MMA(1, 0, At, B0); PG8_MMA(1, 1, At, B1); PG8_BAR; PG8_SCHED;
            PG8_LDB(B0, 1, 0); PG8_LDB(B1, 1, 1); PG8_SCHED; PG8_LDA(At, 1, 0); PG8_STAGE(PG8_SA(0, 1), a2 + hstepA, voffA);
            PG8_WAIT_V(8); PG8_WAIT_L(0); PG8_BAR; PG8_MMA(0, 0, At, B0); PG8_MMA(0, 1, At, B1); PG8_BAR; PG8_SCHED;
            PG8_LDA(At, 1, 1); PG8_STAGE(PG8_SB(1, 0), b3, voffB); PG8_STAGE(PG8_SB(1, 1), b3 + hstepB, voffB); PG8_STAGE(PG8_SA(1, 0), a3, voffA);
            PG8_WAIT_V(8); PG8_WAIT_L(0); PG8_BAR; PG8_MMA(1, 0, At, B0); PG8_MMA(1, 1, At, B1); PG8_BAR; PG8_SCHED;
            } else {
            PG8_LDB(B0, 0, 0); PG8_SCHED; PG8_LDA(At, 0, 0); PG8_STAGE(PG8_SA(1, 1), a1 + hstepA, voffA);
            PG8_WAIT_L(8); PG8_BAR; PG8_WAIT_L(0); PG8_MMA(0, 0, At, B0); PG8_BAR; PG8_SCHED;
            PG8_LDB(B1, 0, 1); PG8_STAGE(PG8_SB(0, 0), b2, voffB);
            PG8_BAR; PG8_WAIT_L(0); PG8_MMA(0, 1, At, B1); PG8_BAR;
            PG8_LDA(At, 0, 1); PG8_STAGE(PG8_SA(0, 0), a2, voffA);
            PG8_BAR; PG8_WAIT_L(0); PG8_MMA(1, 0, At, B0); PG8_BAR; PG8_SCHED;
            PG8_STAGE(PG8_SB(0, 1), b2 + hstepB, voffB);
            PG8_WAIT_V(6); PG8_BAR; PG8_MMA(1, 1, At, B1); PG8_BAR;
            PG8_LDB(B0, 1, 0); PG8_SCHED; PG8_LDA(At, 1, 0); PG8_STAGE(PG8_SA(0, 1), a2 + hstepA, voffA);
            PG8_WAIT_L(8); PG8_BAR; PG8_WAIT_L(0); PG8_MMA(0, 0, At, B0); PG8_BAR; PG8_SCHED;
            PG8_LDB(B1, 1, 1); PG8_STAGE(PG8_SB(1, 0), b3, voffB);
            PG8_BAR; PG8_WAIT_L(0); PG8_MMA(0, 1, At, B1); PG8_BAR;
            PG8_LDA(At, 1, 1); PG8_STAGE(PG8_SA(1, 0), a3, voffA);
            PG8_BAR; PG8_WAIT_L(0); PG8_MMA(1, 0, At, B0); PG8_BAR; PG8_SCHED;
            PG8_STAGE(PG8_SB(1, 1), b3 + hstepB, voffB);
            PG8_WAIT_V(6); PG8_BAR; PG8_MMA(1, 1, At, B1); PG8_BAR;
            }
        }
        if constexpr (ALIGN_EPI) { if (wr == 0) PG8_BAR; }
        if constexpr (!Epi::AFTER_DRAIN) { int lane_e = pg8_lane_id(); asm volatile("" : "+v"(lane_e)); const int fr_e = lane_e & 15, fq_e = lane_e >> 4;     E(acc, cur, wr, wc, fr_e, fq_e); S.done(cur); }
        if (!has_next) break;
#pragma unroll
        for (int a = 0; a < 2; ++a)
#pragma unroll
            for (int b = 0; b < 2; ++b)
#pragma unroll
                for (int m = 0; m < 4; ++m)
#pragma unroll
                    for (int n = 0; n < 2; ++n) acc[a][b][m][n] = (f32x4){0.f, 0.f, 0.f, 0.f};
        cur = nxt; cA = nA; cB = nB; ++ui;
        if constexpr (ALIGN_EPI) { if (wr == 1) PG8_BAR; }
    }
    PG8_WAIT_V(0);
    if constexpr (!ALIGN_EPI) { if (wr == 0) PG8_BAR; }
    PG8_BAR;
    if constexpr (Epi::AFTER_DRAIN) { E.fused(acc, cur, wr, wc, fr, fq, lds, wid, lane); S.done(cur); }
#undef PG8_ACOL
#undef PG8_SA
#undef PG8_SB
#undef PG8_STAGE
#undef PG8_LDA
#undef PG8_LDB
#undef PG8_MMA
#undef PG8_WAIT_V
#undef PG8_WAIT_L
#undef PG8_BAR
#undef PG8_SCHED
}
}


using namespace pg8;
__device__ __forceinline__ int cond_of_pm(int pm) { return pm < 16 ? 0 : 1 + ((pm - 16) >> 2); }

struct EpiResid {
    static constexpr bool PERM = false, AFTER_DRAIN = false;
    const float* xlo; const float* xhi; float* v; const float* gate; const float* colscale;
    __device__ __forceinline__ void operator()(const f32x4 (&acc)[2][2][4][2], const Unit& u, int wr, int wc, int fr, int fq) const {
        const int ci = cond_of_pm(u.pm), col0 = u.pn * BM + wc * 32 + 4 * fq;
        const float* gp = gate + (size_t)ci * 6144 + col0;
        f32x4 gv[2][2];
#pragma unroll
        for (int bj = 0; bj < 2; ++bj)
#pragma unroll
            for (int n = 0; n < 2; ++n) { gv[bj][n] = *(const f32x4*)(gp + bj * HALF + n * 16); if (colscale) gv[bj][n] = gv[bj][n] * *(const f32x4*)(colscale + col0 + bj * HALF + n * 16); }
#pragma unroll
        for (int ai = 0; ai < 2; ++ai)
#pragma unroll
            for (int m = 0; m < 4; ++m) { const int row = u.pm * BM + ai * HALF + wr * 64 + m * 16 + fr;
                const float* xr = (row < MCTX ? xlo + (size_t)row * DM : xhi + (size_t)(row - MCTX) * DM) + col0; float* vr = v + (size_t)row * DM + col0;
#pragma unroll
                for (int bj = 0; bj < 2; ++bj)
#pragma unroll
                    for (int n = 0; n < 2; ++n) { const f32x4 xv = *(const f32x4*)(xr + bj * HALF + n * 16); *(f32x4*)(vr + bj * HALF + n * 16) = xv * ALPHA + gv[bj][n] * acc[ai][bj][m][n]; }
                if (m & 1) asm volatile("" ::: "memory"); __builtin_amdgcn_sched_barrier(0); }
    }
};

struct EpiSwiGLU {
    static constexpr bool PERM = true, AFTER_DRAIN = false;
    bf16* act;
    __device__ __forceinline__ void operator()(const f32x4 (&acc)[2][2][4][2], const Unit& u, int wr, int wc, int fr, int fq) const {
        const int col0 = u.pn * HALF + wc * 32 + 8 * fq;
#pragma unroll
        for (int ai = 0; ai < 2; ++ai)
#pragma unroll
            for (int m = 0; m < 4; ++m) { const int row = u.pm * BM + ai * HALF + wr * 64 + m * 16 + fr;
                f32x4 r0, r1;
#pragma unroll
                for (int j = 0; j < 4; ++j) { const float a0 = acc[ai][0][m][0][j], a1 = acc[ai][0][m][1][j];
                    r0[j] = a0 * fsigmoid(a0) * acc[ai][1][m][0][j]; r1[j] = a1 * fsigmoid(a1) * acc[ai][1][m][1][j]; }
                u32x4 w; w.x = cvt_pk_bf16(r0[0], r0[1]); w.y = cvt_pk_bf16(r0[2], r0[3]); w.z = cvt_pk_bf16(r1[0], r1[1]); w.w = cvt_pk_bf16(r1[2], r1[3]);
                *(u32x4*)(act + (size_t)row * DFF + col0) = w; }
    }
};

struct EpiF32 {
    static constexpr bool PERM = false, AFTER_DRAIN = false;
    float* C; int ldc;
    __device__ __forceinline__ void operator()(const f32x4 (&acc)[2][2][4][2], const Unit& u, int wr, int wc, int fr, int fq) const {
        const int row0 = u.pm * BM + wr * 64 + fr, col0 = u.pn * BM + wc * 32 + 4 * fq;
#pragma unroll
        for (int ai = 0; ai < 2; ++ai)
#pragma unroll
            for (int m = 0; m < 4; ++m) { float* rowp = C + (size_t)(row0 + ai * HALF + m * 16) * ldc + col0;
#pragma unroll
                for (int bj = 0; bj < 2; ++bj)
#pragma unroll
                    for (int n = 0; n < 2; ++n) *(f32x4*)(rowp + bj * HALF + n * 16) = acc[ai][bj][m][n]; }
    }
};

struct EpiQ {
    static constexpr bool PERM = false, AFTER_DRAIN = false;
    bf16* q; const float* rope;
    __device__ __forceinline__ void operator()(const f32x4 (&acc)[2][2][4][2], const Unit& u, int wr, int wc, int fr, int fq) const {
        const int col0 = u.pn * BM + wc * 32 + 4 * fq;
#pragma unroll
        for (int bj = 0; bj < 2; ++bj) { const int g32 = 8 * u.pn + 4 * bj + wc, gi = g32 % 6;
            const bool rot = (gi >= 4) && (u.pm >= 16);
#pragma unroll
            for (int ai = 0; ai < 2; ++ai)
#pragma unroll
                for (int m = 0; m < 4; ++m) { const int row = u.pm * BM + ai * HALF + wr * 64 + m * 16 + fr;
                    f32x4 x1 = acc[ai][bj][m][0], x2 = acc[ai][bj][m][1];
                    if (rot) { const int t = (row - MCTX) & 1023, pos = (gi == 4) ? (t >> 6) : (t & 63); const float* rp = rope + (pos * 16 + 4 * fq) * 2;
                        const f32x4 cs0 = *(const f32x4*)rp, cs1 = *(const f32x4*)(rp + 4);
                        const f32x4 c = (f32x4){cs0[0], cs0[2], cs1[0], cs1[2]}, s = (f32x4){cs0[1], cs0[3], cs1[1], cs1[3]};
                        const f32x4 o1 = x1 * c - x2 * s, o2 = x2 * c + x1 * s; x1 = o1; x2 = o2; }
                    bf16* qp = q + (size_t)row * 1536 + col0 + bj * HALF;
                    v2u w1, w2; w1.x = cvt_pk_bf16(x1[0], x1[1]); w1.y = cvt_pk_bf16(x1[2], x1[3]); w2.x = cvt_pk_bf16(x2[0], x2[1]); w2.y = cvt_pk_bf16(x2[2], x2[3]);
                    *(v2u*)qp = w1; *(v2u*)(qp + 16) = w2; asm volatile("" ::: "memory"); __builtin_amdgcn_sched_barrier(0); } }
    }
};

struct EpiKV {
    static constexpr bool PERM = true, AFTER_DRAIN = false;
    bf16* kn; bf16* vv;
    __device__ __forceinline__ void operator()(const f32x4 (&acc)[2][2][4][2], const Unit& u, int wr, int wc, int fr, int fq) const {
        bf16* base = (u.pn < 4) ? kn : vv; const int col0 = (u.pn & 3) * BM + wc * 32 + 8 * fq;
#pragma unroll
        for (int ai = 0; ai < 2; ++ai)
#pragma unroll
            for (int m = 0; m < 4; ++m) { const int row = u.pm * BM + ai * HALF + wr * 64 + m * 16 + fr;
#pragma unroll
                for (int bj = 0; bj < 2; ++bj) { const f32x4 v0 = acc[ai][bj][m][0], v1 = acc[ai][bj][m][1];
                    u32x4 w; w.x = cvt_pk_bf16(v0[0], v0[1]); w.y = cvt_pk_bf16(v0[2], v0[3]); w.z = cvt_pk_bf16(v1[0], v1[1]); w.w = cvt_pk_bf16(v1[2], v1[3]);
                    *(u32x4*)(base + (size_t)row * DM + col0 + bj * HALF) = w; } asm volatile("" ::: "memory"); __builtin_amdgcn_sched_barrier(0); }
    }
};

__device__ __forceinline__ float gelu_tanh(float x) { const float z2 = 1.5957691216057308f * (x + 0.044715f * x * x * x); return x * __builtin_amdgcn_rcpf(1.0f + __expf(-z2)); }

struct EpiLruIn {
    static constexpr bool PERM = false, AFTER_DRAIN = false;
    float* uo; bf16* yo;
    __device__ __forceinline__ void operator()(const f32x4 (&acc)[2][2][4][2], const Unit& u, int wr, int wc, int fr, int fq) const {
        const int col0 = (u.pn & 3) * BM + wc * 32 + 4 * fq;
#pragma unroll
        for (int ai = 0; ai < 2; ++ai)
#pragma unroll
            for (int m = 0; m < 4; ++m) { const int row = u.pm * BM + ai * HALF + wr * 64 + m * 16 + fr;
#pragma unroll
                for (int bj = 0; bj < 2; ++bj)
#pragma unroll
                    for (int n = 0; n < 2; ++n) { const f32x4 a = acc[ai][bj][m][n]; const size_t off = (size_t)row * DM + col0 + bj * HALF + n * 16;
                        if (u.pn < 4) *(f32x4*)(uo + off) = a;
                        else { v2u w; w.x = cvt_pk_bf16(gelu_tanh(a[0]), gelu_tanh(a[1])); w.y = cvt_pk_bf16(gelu_tanh(a[2]), gelu_tanh(a[3])); *(v2u*)(yo + off) = w; } } }
    }
};

struct EpiGates {
    static constexpr bool PERM = false, AFTER_DRAIN = false;
    const bf16* uc; const float* b_a; const float* b_i; const float* sp; float* af; float* ab; bf16* bfo; bf16* bbo;
    __device__ __forceinline__ void operator()(const f32x4 (&acc)[2][2][4][2], const Unit& u, int wr, int wc, int fr, int fq) const {
        const int ch0 = 256 * (u.pn >> 2) + 64 * (u.pn & 3) + 16 * wc + 4 * fq;
        const f32x4 baf = *(const f32x4*)(b_a + ch0), bab = *(const f32x4*)(b_a + 1024 + ch0), bif = *(const f32x4*)(b_i + ch0), bib = *(const f32x4*)(b_i + 1024 + ch0);
        const f32x4 spf = *(const f32x4*)(sp + ch0), spb = *(const f32x4*)(sp + 1024 + ch0);
#pragma unroll
        for (int ai = 0; ai < 2; ++ai)
#pragma unroll
            for (int m = 0; m < 4; ++m) { const int row = u.pm * BM + ai * HALF + wr * 64 + m * 16 + fr; const size_t off = (size_t)row * DM + ch0;
                const v2u uw = *(const v2u*)(uc + off); const f32x4 uu = (f32x4){bf2f(uw.x & 0xffffu), bf2f(uw.x >> 16), bf2f(uw.y & 0xffffu), bf2f(uw.y >> 16)};
                f32x4 a_f, a_b, b_f, b_b;
#pragma unroll
                for (int j = 0; j < 4; ++j) {
                    const float rf = fsigmoid(acc[ai][0][m][0][j] + baf[j]), rb = fsigmoid(acc[ai][0][m][1][j] + bab[j]);
                    const float gf = fsigmoid(acc[ai][1][m][0][j] + bif[j]), gb = fsigmoid(acc[ai][1][m][1][j] + bib[j]);
                    const float laf = -8.0f * rf * spf[j], lab = -8.0f * rb * spb[j];
                    a_f[j] = __expf(laf); a_b[j] = __expf(lab);
                    b_f[j] = sqrtf(-expm1f(2.0f * laf)) * (gf * uu[j]); b_b[j] = sqrtf(-expm1f(2.0f * lab)) * (gb * uu[j]); }
                *(f32x4*)(af + off) = a_f; *(f32x4*)(ab + off) = a_b;
                v2u w1, w2; w1.x = cvt_pk_bf16(b_f[0], b_f[1]); w1.y = cvt_pk_bf16(b_f[2], b_f[3]); w2.x = cvt_pk_bf16(b_b[0], b_b[1]); w2.y = cvt_pk_bf16(b_b[2], b_b[3]);
                *(v2u*)(bfo + off) = w1; *(v2u*)(bbo + off) = w2; asm volatile("" ::: "memory"); __builtin_amdgcn_sched_barrier(0); }
    }
};


#define XB_TMO      128
#define XB_XCNT(j)  (256  + 64 * (j))
#define XB_XSUB(j)  (1280 + 64 * (j))
#define XB_XGEN(j)  (2304 + 64 * (j))
#define XB_TOP      3328
#define XB_TOPGEN   3392
#define XCD_BAR_WORDS 3456
#define XB_SPIN_CAP (1u << 18)
__device__ __forceinline__ unsigned xb_ld(unsigned* p)              { return __hip_atomic_load(p, __ATOMIC_RELAXED, __HIP_MEMORY_SCOPE_AGENT); }
__device__ __forceinline__ unsigned xb_add(unsigned* p, unsigned v) { return __hip_atomic_fetch_add(p, v, __ATOMIC_RELAXED, __HIP_MEMORY_SCOPE_AGENT); }
__device__ __forceinline__ unsigned xb_xcc_id() { return (unsigned)__builtin_amdgcn_s_getreg((3 << 11) | 20) & 0xFu; }
#define XB_SPIN(cond, bar) do { unsigned _sp = 0; while (cond) { __builtin_amdgcn_s_sleep(1); \
    if ((++_sp & 255u) == 0u) { if (xb_ld(&(bar)[XB_TMO])) break; if (_sp > XB_SPIN_CAP) { atomicAdd(&(bar)[XB_TMO], 1u); break; } } } } while (0)
struct XcdBarrier { unsigned* bar; unsigned x; volatile LAS unsigned* st; };
__device__ __forceinline__ XcdBarrier xcd_barrier_post(unsigned* bar, volatile LAS unsigned* st, int tid) {
    XcdBarrier b; b.bar = bar; b.x = xb_xcc_id(); b.st = st;
    if (tid == 0) (void)xb_add(&bar[XB_XCNT(b.x)], 1u);
    return b;
}
__device__ __forceinline__ void xcd_barrier_complete(unsigned* bar, unsigned x, unsigned& nloc, unsigned& nx) {
    const unsigned G = gridDim.x * gridDim.y * gridDim.z;
    unsigned sum, cnt, mine, sp = 0u;
    for (;;) {
        sum = 0u; cnt = 0u; mine = 0u;
#pragma unroll
        for (unsigned j = 0; j < 16; ++j) { const unsigned c = xb_ld(&bar[XB_XCNT(j)]); sum += c; cnt += (c > 0u) ? 1u : 0u; mine = (j == x) ? c : mine; }
        if (sum == G) break;
        __builtin_amdgcn_s_sleep(1);
        if ((++sp & 255u) == 0u) { if (xb_ld(&bar[XB_TMO])) break; if (sp > XB_SPIN_CAP) { atomicAdd(&bar[XB_TMO], 1u); break; } }
    }
    nloc = mine > 0u ? mine : 1u; nx = cnt > 0u ? cnt : 1u;
}
__device__ __forceinline__ void xcd_barrier(const XcdBarrier& b, int tid) {
    asm volatile("s_waitcnt vmcnt(0)" ::: "memory");
    __syncthreads();
    if (tid == 0) {
        unsigned* bar = b.bar;
        __builtin_amdgcn_s_waitcnt(0);
        unsigned nloc = b.st[0], nx = b.st[1];
        if (nloc == 0u) { xcd_barrier_complete(bar, b.x, nloc, nx); b.st[0] = nloc; b.st[1] = nx; }
        const unsigned old = xb_add(&bar[XB_XSUB(b.x)], 1u);
        const unsigned gen = old / nloc;
        if (old + 1u == (gen + 1u) * nloc) {
            __builtin_amdgcn_fence(__ATOMIC_RELEASE, "agent");
            asm volatile("s_waitcnt vmcnt(0)" ::: "memory");
            const unsigned og = xb_add(&bar[XB_TOP], 1u);
            const unsigned tg = og / nx;
            if (og + 1u == (tg + 1u) * nx) xb_add(&bar[XB_TOPGEN], 1u);
            else XB_SPIN(xb_ld(&bar[XB_TOPGEN]) == tg, bar);
            __builtin_amdgcn_fence(__ATOMIC_ACQUIRE, "agent");
            xb_add(&bar[XB_XGEN(b.x)], 1u);
            asm volatile("s_waitcnt vmcnt(0)" ::: "memory");
        } else {
            XB_SPIN(xb_ld(&bar[XB_XGEN(b.x)]) == gen, bar);
            __builtin_amdgcn_fence(__ATOMIC_ACQUIRE, "agent");
            asm volatile("s_waitcnt vmcnt(0)" ::: "memory");
        }
    }
    __syncthreads();
}

struct Args { const float* in[32]; float* out; unsigned char* ws; int ph_lo, ph_hi; };
enum { I_XP = 0, I_XS, I_CCKV, I_CKR, I_STATE, I_C, I_CCTX, I_WADA, I_BADA, I_LNG, I_LNB, I_WFIN, I_WFOUT, I_WPOOL, I_PSCALE, I_WDQ, I_GQ, I_WUQ, I_WDKV, I_GKV, I_WUK, I_WUV, I_WO,
       I_WLIN, I_CONVW, I_CONVB, I_WLA, I_BLA, I_WLI, I_BLI, I_LAM, I_WLOUT };
struct Ctx {
    LAS unsigned char* lds; int tid, lane, wave, G, gw, NGW, gt, NT;
    const float* const* in; float* out; unsigned char* ws;
};
__device__ __forceinline__ const float* mod_layer(const Ctx& F, int l) { return (const float*)(F.ws + WS_MOD) + (size_t)l * 9 * 6144; }

struct RmOff { int off; __device__ __forceinline__ int operator()(int n) const { return n + off; } };
struct RmSwi { __device__ __forceinline__ int operator()(int n) const { return n < DFF ? 256 * (n >> 7) + (n & 127) : 256 * ((n - DFF) >> 7) + 128 + ((n - DFF) & 127); } };
template <class RM>
__device__ __forceinline__ void p0_transpose_item(const float* W, int ldw, int K, bf16* WT, LAS float* scr, int item, int lane, RM rm) {
    const int nblk = ldw / 32, kb = item / nblk, nb = item % nblk, k0 = 64 * kb, n0 = 32 * nb;
#pragma unroll 8
    for (int i = 0; i < 32; ++i) { const int kk = 2 * i + (lane >> 5); scr[kk * 33 + (lane & 31)] = W[(size_t)(k0 + kk) * ldw + n0 + (lane & 31)]; }
    LDS_WAIT(); asm volatile("" ::: "memory");
    const int c = lane & 7;
#pragma unroll
    for (int j = 0; j < 4; ++j) { const int n = (lane >> 3) + 8 * j; const LAS float* s = scr + (8 * c) * 33 + n;
        v4u o; o.x = pk2(s[0 * 33], s[1 * 33]); o.y = pk2(s[2 * 33], s[3 * 33]); o.z = pk2(s[4 * 33], s[5 * 33]); o.w = pk2(s[6 * 33], s[7 * 33]);
        *(v4u*)(WT + (size_t)rm(n0 + n) * K + k0 + 8 * c) = o; }
    LDS_WAIT(); asm volatile("" ::: "memory");
}

__device__ __forceinline__ void p0_prologue(Ctx& F) {
    const float* const* in = F.in; unsigned char* ws = F.ws;
    {
        LAS float* S = (LAS float*)F.lds;
        LAS float* P = (LAS float*)(F.lds + 36864);
        if ((int)blockIdx.x < 192) {
            for (int i = F.tid; i < 9 * 1024; i += 512) { const int ci = i >> 10, k = i & 1023; const float c = ci == 0 ? in[I_CCTX][k] : in[I_C][(ci - 1) * 1024 + k]; S[i] = c * fsigmoid(c); }
            __syncthreads();
            for (int item = blockIdx.x; item < 192; item += F.G) {
                const int l = item / 48, n0 = (item % 48) * 128, cg = F.tid & 31, kg = F.tid >> 5;
                const float* wp = in[I_WADA] + ((size_t)l * 1024 + kg * 64) * 6144 + n0 + 4 * cg;
                f32x4 acc[9];
#pragma unroll
                for (int ci = 0; ci < 9; ++ci) acc[ci] = (f32x4){0.f, 0.f, 0.f, 0.f};
#pragma unroll 4
                for (int kk = 0; kk < 64; ++kk) { const f32x4 w = *(const f32x4*)(wp + (size_t)kk * 6144);
#pragma unroll
                    for (int ci = 0; ci < 9; ++ci) acc[ci] += w * S[ci * 1024 + kg * 64 + kk]; }
#pragma unroll
                for (int ci = 0; ci < 9; ++ci) *(LAS f32x4*)(P + (kg * 9 + ci) * 128 + 4 * cg) = acc[ci];
                __syncthreads();
                for (int o = F.tid; o < 9 * 128; o += 512) { const int ci = o >> 7, c = o & 127; float s = in[I_BADA][l * 6144 + n0 + c];
#pragma unroll
                    for (int g = 0; g < 16; ++g) s += P[(g * 9 + ci) * 128 + c];
                    ((float*)(ws + WS_MOD))[((size_t)l * 9 + ci) * 6144 + n0 + c] = s; }
                __syncthreads();
            }
        }
        __syncthreads();
    }
    {
        LAS float* scr = (LAS float*)(F.lds + F.wave * 8448);
        constexpr int C0 = 4 * 16 * 176, C1 = C0 + 4 * 44 * 32, C2 = C1 + 8 * 32, C3 = C2 + 16 * 12, C4 = C3 + 16 * 10, C5 = C4 + 6 * 48, C6 = C5 + 4 * 32, C7 = C6 + 4 * 32, C8 = C7 + 16 * 32, C9 = C8 + 16 * 64, C10 = C9 + 16 * 32;
        for (int it = F.gw; it < C10; it += F.NGW) {
            if (it < C0) { const int l = it / 2816, r = it % 2816; p0_transpose_item(in[I_WFIN] + (size_t)l * 1024 * 5632, 5632, 1024, (bf16*)(ws + W_FFN_IN) + (size_t)l * 5632 * 1024, scr, r, F.lane, RmSwi{}); }
            else if (it < C1) { const int q = it - C0, l = q / 1408, r = q % 1408; p0_transpose_item(in[I_WFOUT] + (size_t)l * DFF * 1024, 1024, DFF, (bf16*)(ws + W_FFN_OUT) + (size_t)l * 1024 * DFF, scr, r, F.lane, RmOff{0}); }
            else if (it < C2) { const int q = it - C1, mi = q / 32, r = q % 32; p0_transpose_item(in[I_WPOOL] + (size_t)mi * 65536, 256, 256, (bf16*)(ws + W_POOL) + (size_t)mi * 65536, scr, r, F.lane, RmOff{0}); }
            else if (it < C3) p0_transpose_item(in[I_WDQ], 384, 1024, (bf16*)(ws + W_DQKV), scr, it - C2, F.lane, RmOff{0});
            else if (it < C4) p0_transpose_item(in[I_WDKV], 320, 1024, (bf16*)(ws + W_DQKV), scr, it - C3, F.lane, RmOff{384});
            else if (it < C5) p0_transpose_item(in[I_WUQ], 1536, 384, (bf16*)(ws + W_UQ), scr, it - C4, F.lane, RmOff{0});
            else if (it < C6) p0_transpose_item(in[I_WUK], 1024, 256, (bf16*)(ws + W_UKV), scr, it - C5, F.lane, RmOff{0});
            else if (it < C7) p0_transpose_item(in[I_WUV], 1024, 256, (bf16*)(ws + W_UKV), scr, it - C6, F.lane, RmOff{1024});
            else if (it < C8) p0_transpose_item(in[I_WO], 1024, 1024, (bf16*)(ws + W_O), scr, it - C7, F.lane, RmOff{0});
            else if (it < C9) p0_transpose_item(in[I_WLIN], 2048, 1024, (bf16*)(ws + W_LIN), scr, it - C8, F.lane, RmOff{0});
            else p0_transpose_item(in[I_WLOUT], 1024, 1024, (bf16*)(ws + W_LOUT), scr, it - C9, F.lane, RmOff{0});
        }
    }
    for (int it = F.gt; it < 4096 * 32; it += F.NT) {
        const int R = it >> 5, kc = it & 31, pn = R >> 8, cc = R & 255, jp = pn >> 2, q = pn & 3;
        const int bj = cc >> 7, wc = (cc >> 5) & 3, n = (cc >> 4) & 1, e = cc & 15, d = n, isI = bj, nb = 2 * jp + (q >> 1), mch = 64 * (q & 1) + 16 * wc + e;
        v4u o = (v4u){0u, 0u, 0u, 0u};
        if ((kc >> 4) == (q >> 1)) { const float* W = (isI ? in[I_WLI] : in[I_WLA]) + ((size_t)(d * 8 + nb) * 128 + (kc & 15) * 8) * 128 + mch;
            o.x = pk2(W[0], W[128]); o.y = pk2(W[256], W[384]); o.z = pk2(W[512], W[640]); o.w = pk2(W[768], W[896]); }
        *(v4u*)((bf16*)(ws + W_GATE) + (size_t)R * 256 + kc * 8) = o;
    }
    for (int it = F.gt; it < 1024; it += F.NT) { const int pos = it >> 4, f = it & 15; const double inv = exp(-(double)f / 16.0 * 9.210340371976184  ); const float ang = (float)pos * (float)inv;
        float s, c; sincosf(ang, &s, &c); ((float*)(ws + WS_ROPE))[2 * it] = c; ((float*)(ws + WS_ROPE))[2 * it + 1] = s; }
    for (int it = F.gt; it < 2048; it += F.NT) ((float*)(ws + WS_SP))[it] = (float)log1p(exp(-(double)in[I_LAM][it]));
    for (int it = F.gt; it < 64 * 1024 / 8; it += F.NT) *(v4u*)((bf16*)(ws + W_DQKV) + (size_t)704 * 1024 + it * 8) = (v4u){0u, 0u, 0u, 0u};
}

__device__ __forceinline__ void ln_phase(Ctx& F, const float* v, float* xo, bf16* ho, const float* g, const float* b, const float* modl, int w_sh, int w_sc) {
    for (int row = F.gw; row < MT; row += F.NGW) {
        const f32x4* vr = (const f32x4*)(v + (size_t)row * DM) + F.lane;
        f32x4 x[4]; float s = 0.f;
#pragma unroll
        for (int j = 0; j < 4; ++j) { x[j] = vr[64 * j]; s += (x[j][0] + x[j][1]) + (x[j][2] + x[j][3]); }
        const float mean = wave_sum(s, F.lane) * (1.f / DM); float s2 = 0.f;
#pragma unroll
        for (int j = 0; j < 4; ++j) { x[j] = x[j] - mean; s2 += (x[j][0] * x[j][0] + x[j][1] * x[j][1]) + (x[j][2] * x[j][2] + x[j][3] * x[j][3]); }
        const float rstd = 1.f / sqrtf(wave_sum(s2, F.lane) * (1.f / DM) + LN_EPS);
        const int ci = cond_of_row(row);
#pragma unroll
        for (int j = 0; j < 4; ++j) { const int col = 4 * F.lane + 256 * j;
            const f32x4 y = x[j] * rstd * *(const f32x4*)(g + col) + *(const f32x4*)(b + col);
            *(f32x4*)(xo + (size_t)row * DM + col) = y;
            if (ho) { const f32x4 sc = *(const f32x4*)(modl + (size_t)ci * 6144 + w_sc * 1024 + col), sh = *(const f32x4*)(modl + (size_t)ci * 6144 + w_sh * 1024 + col);
                const f32x4 h = y * (1.0f + sc) + sh; v2u w; w.x = cvt_pk_bf16(h[0], h[1]); w.y = cvt_pk_bf16(h[2], h[3]); *(v2u*)(ho + (size_t)row * DM + col) = w; } }
    }
}

__device__ __forceinline__ void pool_ew_phase(Ctx& F, const float* xlo, const float* xhi, const float* modl, bf16* po) {
    for (int it = F.gt; it < 384 * 256; it += F.NT) {
        const int tc = it >> 8, c4 = it & 255, col = 4 * c4, half = 1 << (c4 >> 6), row0 = tc * 32;
        const int T = row0 < MCTX ? 256 : 1024, s0 = row0 < MCTX ? (row0 & ~255) : MCTX + ((row0 - MCTX) & ~1023), t0 = row0 - s0;
        const float* xb = (row0 < MCTX ? xlo + (size_t)s0 * DM : xhi + (size_t)(s0 - MCTX) * DM) + col;
        const f32x4 sc1 = 1.0f + *(const f32x4*)(modl + (size_t)cond_of_row(row0) * 6144 + 1 * 1024 + col);
        f32x4 sum = (f32x4){0.f, 0.f, 0.f, 0.f};
        { const int lo = t0 - half > 0 ? t0 - half : 0, hi = t0 + half < T ? t0 + half : T; for (int s = lo; s < hi; ++s) sum += *(const f32x4*)(xb + (size_t)s * DM); }
        for (int i = 0; i < 32; ++i) { const int t = t0 + i, lo = t - half > 0 ? t - half : 0, hi = t + half < T ? t + half : T;
            const f32x4 xc = *(const f32x4*)(xb + (size_t)t * DM); const f32x4 p = (sum * (1.0f / (float)(hi - lo)) - xc) * sc1;
            v2u w; w.x = cvt_pk_bf16(p[0], p[1]); w.y = cvt_pk_bf16(p[2], p[3]); *(v2u*)(po + (size_t)(s0 + t) * DM + col) = w;
            if (t + half < T) sum += *(const f32x4*)(xb + (size_t)(t + half) * DM);
            if (t - half >= 0) sum -= *(const f32x4*)(xb + (size_t)(t - half) * DM); }
    }
}

__device__ __forceinline__ int keyrow_of(int row) { return row < MCTX ? row : MCTX + ((row - MCTX) >> 10) * 1280 + 256 + ((row - MCTX) & 1023); }
__device__ __forceinline__ void mla_post_phase(Ctx& F) {
    const float* raw = (const float*)(F.ws + T_RAW); bf16* qn = (bf16*)(F.ws + T_QN); bf16* ckv = (bf16*)(F.ws + T_CKV); bf16* kra = (bf16*)(F.ws + T_KRA);
    const float* rope = (const float*)(F.ws + WS_ROPE); const float* g_q = F.in[I_GQ]; const float* g_kv = F.in[I_GKV]; const int lane = F.lane;
    for (int row = F.gw; row < MT; row += F.NGW) {
        const float* r = raw + (size_t)row * 768;
        f32x2 q[3]; float s = 0.f;
#pragma unroll
        for (int j = 0; j < 3; ++j) { q[j] = *(const f32x2*)(r + 2 * lane + 128 * j); s += q[j][0] * q[j][0] + q[j][1] * q[j][1]; }
        const float rq = 1.f / sqrtf(wave_sum(s, lane) * (1.f / 384.f) + LN_EPS);
#pragma unroll
        for (int j = 0; j < 3; ++j) { const int col = 2 * lane + 128 * j; const f32x2 gq = *(const f32x2*)(g_q + col); *(unsigned*)(qn + (size_t)row * 384 + col) = cvt_pk_bf16(q[j][0] * rq * gq[0], q[j][1] * rq * gq[1]); }
        const f32x4 c = *(const f32x4*)(r + 384 + 4 * lane); const float sc = (c[0] * c[0] + c[1] * c[1]) + (c[2] * c[2] + c[3] * c[3]);
        const float rc = 1.f / sqrtf(wave_sum(sc, lane) * (1.f / 256.f) + LN_EPS);
        const f32x4 cn = c * rc * *(const f32x4*)(g_kv + 4 * lane);
        const int kr_row = keyrow_of(row);
        { v2u w; w.x = cvt_pk_bf16(cn[0], cn[1]); w.y = cvt_pk_bf16(cn[2], cn[3]); *(v2u*)(ckv + (size_t)kr_row * 256 + 4 * lane) = w; }
        float k = r[640 + lane];
        if (row < MCTX) { *(f32x4*)(F.out + O_CKV + (size_t)row * 256 + 4 * lane) = cn; F.out[O_KR + (size_t)row * 64 + lane] = k; }
        const float partner = shfl_xor_l(k, 16, lane);
        if (row >= MCTX) { const int t = (row - MCTX) & 1023, pos = (lane < 32) ? (t >> 6) : (t & 63), f = lane & 15; const float cc = rope[(pos * 16 + f) * 2], ss = rope[(pos * 16 + f) * 2 + 1];
            k = (lane & 16) ? (k * cc + partner * ss) : (k * cc - partner * ss); }
        kra[(size_t)kr_row * 64 + lane] = (bf16)f2bf(k);
    }
    for (int r2 = F.gw; r2 < 2048; r2 += F.NGW) {
        const int b = r2 >> 8, s = r2 & 255, kr_row = MCTX + b * 1280 + s;
        const f32x4 c = *(const f32x4*)(F.in[I_CCKV] + (size_t)r2 * 256 + 4 * lane);
        v2u w; w.x = cvt_pk_bf16(c[0], c[1]); w.y = cvt_pk_bf16(c[2], c[3]); *(v2u*)(ckv + (size_t)kr_row * 256 + 4 * lane) = w;
        kra[(size_t)kr_row * 64 + lane] = (bf16)f2bf(F.in[I_CKR][(size_t)r2 * 64 + lane]);
    }
}

__device__ __forceinline__ void lru_conv_phase(Ctx& F) {
    const float* u = (const float*)(F.ws + WS_VTMP); bf16* uc = (bf16*)(F.ws + T_UCONV); const float* cw = F.in[I_CONVW]; const float* cb = F.in[I_CONVB];
    for (int it = F.gt; it < 384 * 256; it += F.NT) {
        const int tc = it >> 8, col = 4 * (it & 255), row0 = tc * 32;
        const int T = row0 < MCTX ? 256 : 1024, s0 = row0 < MCTX ? (row0 & ~255) : MCTX + ((row0 - MCTX) & ~1023), t0 = row0 - s0;
        const float* ub = u + (size_t)s0 * DM + col;
        const f32x4 w0 = *(const f32x4*)(cw + col), w1 = *(const f32x4*)(cw + 1024 + col), w2 = *(const f32x4*)(cw + 2048 + col), w3 = *(const f32x4*)(cw + 3072 + col), bb = *(const f32x4*)(cb + col);
        const f32x4 z = (f32x4){0.f, 0.f, 0.f, 0.f};
        f32x4 um = t0 > 0 ? *(const f32x4*)(ub + (size_t)(t0 - 1) * DM) : z, u0 = *(const f32x4*)(ub + (size_t)t0 * DM), u1 = t0 + 1 < T ? *(const f32x4*)(ub + (size_t)(t0 + 1) * DM) : z;
        for (int i = 0; i < 32; ++i) { const int t = t0 + i; const f32x4 u2 = t + 2 < T ? *(const f32x4*)(ub + (size_t)(t + 2) * DM) : z;
            const f32x4 o = um * w0 + u0 * w1 + u1 * w2 + u2 * w3 + bb;
            v2u w; w.x = cvt_pk_bf16(o[0], o[1]); w.y = cvt_pk_bf16(o[2], o[3]); *(v2u*)(uc + (size_t)(s0 + t) * DM + col) = w;
            um = u0; u0 = u1; u1 = u2; }
    }
}

__device__ __forceinline__ void lru_scan1_phase(Ctx& F) {
    const float* af = (const float*)(F.ws + T_AF); const float* ab = (const float*)(F.ws + T_AB); const bf16* bfp = (const bf16*)(F.ws + T_BF); const bf16* bbp = (const bf16*)(F.ws + T_BB);
    float* sum = (float*)(F.ws + T_SUM);
    for (int it = F.gt; it < 384 * 512; it += F.NT) {
        const int c32 = it >> 9, ch = 2 * (it & 511); const size_t base = (size_t)c32 * 32 * DM + ch;
        f32x2 A = (f32x2){1.f, 1.f}, B = (f32x2){0.f, 0.f};
#pragma unroll 8
        for (int i = 0; i < 32; ++i) { const f32x2 a = *(const f32x2*)(af + base + (size_t)i * DM); const unsigned bw = *(const unsigned*)(bfp + base + (size_t)i * DM);
            B = a * B + (f32x2){bf2f(bw & 0xffffu), bf2f(bw >> 16)}; A = A * a; }
        *(f32x2*)(sum + ((size_t)0 * 384 + c32) * DM + ch) = A; *(f32x2*)(sum + ((size_t)1 * 384 + c32) * DM + ch) = B;
        A = (f32x2){1.f, 1.f}; B = (f32x2){0.f, 0.f};
#pragma unroll 8
        for (int i = 31; i >= 0; --i) { const f32x2 a = *(const f32x2*)(ab + base + (size_t)i * DM); const unsigned bw = *(const unsigned*)(bbp + base + (size_t)i * DM);
            B = a * B + (f32x2){bf2f(bw & 0xffffu), bf2f(bw >> 16)}; A = A * a; }
        *(f32x2*)(sum + ((size_t)2 * 384 + c32) * DM + ch) = A; *(f32x2*)(sum + ((size_t)3 * 384 + c32) * DM + ch) = B;
    }
}
__device__ __forceinline__ void lru_scan2_phase(Ctx& F) {
    const float* af = (const float*)(F.ws + T_AF); const float* ab = (const float*)(F.ws + T_AB); const bf16* bfp = (const bf16*)(F.ws + T_BF); const bf16* bbp = (const bf16*)(F.ws + T_BB);
    const float* sum = (const float*)(F.ws + T_SUM); const bf16* y = (const bf16*)(F.ws + T_Y); bf16* hs = (bf16*)(F.ws + WS_H);
    for (int it = F.gt; it < 384 * 512; it += F.NT) {
        const int c32 = it >> 9, ch = 2 * (it & 511), row0 = c32 * 32; const size_t base = (size_t)row0 * DM + ch;
        const bool ctx = row0 < MCTX; const int nc = ctx ? 8 : 32, cs = ctx ? (c32 & ~7) : 128 + ((c32 - 128) & ~31);
        f32x2 hf = (f32x2){0.f, 0.f}, hb = (f32x2){0.f, 0.f};
        if (!ctx) { const int b = (row0 - MCTX) >> 10; hf = *(const f32x2*)(F.in[I_STATE] + (size_t)(b * 2 + 0) * DM + ch); hb = *(const f32x2*)(F.in[I_STATE] + (size_t)(b * 2 + 1) * DM + ch); }
        for (int c = cs; c < c32; ++c) hf = *(const f32x2*)(sum + ((size_t)0 * 384 + c) * DM + ch) * hf + *(const f32x2*)(sum + ((size_t)1 * 384 + c) * DM + ch);
        for (int c = cs + nc - 1; c > c32; --c) hb = *(const f32x2*)(sum + ((size_t)2 * 384 + c) * DM + ch) * hb + *(const f32x2*)(sum + ((size_t)3 * 384 + c) * DM + ch);
        f32x2 hfv[32];
#pragma unroll
        for (int i = 0; i < 32; ++i) { const f32x2 a = *(const f32x2*)(af + base + (size_t)i * DM); const unsigned bw = *(const unsigned*)(bfp + base + (size_t)i * DM);
            hf = a * hf + (f32x2){bf2f(bw & 0xffffu), bf2f(bw >> 16)}; hfv[i] = hf; }
#pragma unroll
        for (int i = 31; i >= 0; --i) { const f32x2 a = *(const f32x2*)(ab + base + (size_t)i * DM); const unsigned bw = *(const unsigned*)(bbp + base + (size_t)i * DM);
            hb = a * hb + (f32x2){bf2f(bw & 0xffffu), bf2f(bw >> 16)};
            const unsigned yw = *(const unsigned*)(y + base + (size_t)i * DM);
            *(unsigned*)(hs + base + (size_t)i * DM) = cvt_pk_bf16((hfv[i][0] + hb[0]) * bf2f(yw & 0xffffu), (hfv[i][1] + hb[1]) * bf2f(yw >> 16)); }
        if (ctx) { const int b = row0 >> 8;
            if (c32 == cs + nc - 1) *(f32x2*)(F.out + O_LRU + (size_t)(b * 2 + 0) * DM + ch) = hf;
            if (c32 == cs) *(f32x2*)(F.out + O_LRU + (size_t)(b * 2 + 1) * DM + ch) = hb; }
    }
}


namespace att {
constexpr int QBLK = 32, KVBLK = 64;
constexpr int SHM_V = KVBLK * 128 * 2, SHM_K = KVBLK * 128 * 2, SHM_R = KVBLK * 64 * 2;
constexpr int OFF_V = 0, OFF_K = 2 * SHM_V, OFF_R = OFF_K + 2 * SHM_K, OFF_WS = OFF_R + 2 * SHM_R, LDS_TOTAL = OFF_WS + 8 * 256;
constexpr int LDQ = 1536, LDK = 1024, LDR = 64, LDO = 1024;
constexpr float THR = 8.f;
#define KSWZ(row, colB) ((row) * 256 + ((colB) ^ (((row) & 7) << 4)))
#define RSWZ(row, colB) ((row) * 128 + ((colB) ^ (((row) & 7) << 4)))
#define SBAR() __builtin_amdgcn_sched_barrier(0)
__device__ __forceinline__ int crow(int r, int hi) { return (r & 3) + 8 * (r >> 2) + 4 * hi; }
__device__ __forceinline__ unsigned cvtpk(float lo, float hi) { unsigned r; asm volatile("v_cvt_pk_bf16_f32 %0, %1, %2" : "=v"(r) : "v"(lo), "v"(hi)); return r; }
__device__ __forceinline__ void partialSM(f32x16& p0, f32x16& p1, float& m_reg, float& mn, float& alpha) {
  constexpr float C = MLA_SCALE * 1.4426950408889634f;
  float pmax = p0[0];
#pragma unroll
  for (int r = 1; r < 16; ++r) pmax = fmaxf(pmax, p0[r]);
#pragma unroll
  for (int r = 0; r < 16; ++r) pmax = fmaxf(pmax, p1[r]);
  { auto rr = __builtin_amdgcn_permlane32_swap(__float_as_uint(pmax), __float_as_uint(pmax), false, false);
    pmax = fmaxf(__uint_as_float(rr[0]), __uint_as_float(rr[1])); }
  if (__builtin_expect(__all(pmax - m_reg <= THR / MLA_SCALE), 1)) { mn = m_reg; alpha = 1.f; }
  else { mn = fmaxf(m_reg, pmax); alpha = __builtin_amdgcn_exp2f((m_reg - mn) * C); m_reg = mn; }
  float mnC = -mn * C;
#pragma unroll
  for (int r = 0; r < 16; ++r) p0[r] = fmaf(p0[r], C, mnC);
#pragma unroll
  for (int r = 0; r < 16; ++r) p1[r] = fmaf(p1[r], C, mnC);
#pragma unroll
  for (int r = 0; r < 16; ++r) p0[r] = __builtin_amdgcn_exp2f(p0[r]);
}
__device__ __forceinline__ void finishSM(f32x16& p0, f32x16& p1, float alpha, float& l_reg, bf16x8& pa0, bf16x8& pa1, bf16x8& pa2, bf16x8& pa3) {
#pragma unroll
  for (int r = 0; r < 16; ++r) p1[r] = __builtin_amdgcn_exp2f(p1[r]);
  float ps = 0;
#pragma unroll
  for (int r = 0; r < 16; ++r) ps += p0[r];
#pragma unroll
  for (int r = 0; r < 16; ++r) ps += p1[r];
  { auto rr = __builtin_amdgcn_permlane32_swap(__float_as_uint(ps), __float_as_uint(ps), false, false);
    ps = __uint_as_float(rr[0]) + __uint_as_float(rr[1]); }
  l_reg = l_reg * alpha + ps;
#define PK4(P, BASE, OUT) do { unsigned a0 = cvtpk(P[BASE + 0], P[BASE + 1]), a1 = cvtpk(P[BASE + 2], P[BASE + 3]);   \
    unsigned b0 = cvtpk(P[BASE + 4], P[BASE + 5]), b1 = cvtpk(P[BASE + 6], P[BASE + 7]);                              \
    auto r0 = __builtin_amdgcn_permlane32_swap(a0, b0, false, false); auto r1 = __builtin_amdgcn_permlane32_swap(a1, b1, false, false); \
    u32x4 w = {r0[0], r1[0], r0[1], r1[1]}; OUT = __builtin_bit_cast(bf16x8, w); } while (0)
  PK4(p0, 0, pa0); PK4(p0, 8, pa1); PK4(p1, 0, pa2); PK4(p1, 8, pa3);
#undef PK4
}
__device__ __forceinline__ void qkt(f32x16& p0, f32x16& p1, LAS const unsigned char* Ks, LAS const unsigned char* Rs, const bf16x8* qr, int r32, int hi) {
  p0 = f32x16{}; p1 = f32x16{};
#pragma unroll
  for (int d0 = 0; d0 < 8; ++d0) { const int cb = (d0 * 16 + hi * 8) * 2;
    const bf16x8 b0 = *(LAS const bf16x8*)(Ks + KSWZ(r32, cb)), b1 = *(LAS const bf16x8*)(Ks + KSWZ(32 + r32, cb));
    p0 = __builtin_amdgcn_mfma_f32_32x32x16_bf16(b0, qr[d0], p0, 0, 0, 0);
    p1 = __builtin_amdgcn_mfma_f32_32x32x16_bf16(b1, qr[d0], p1, 0, 0, 0); }
#pragma unroll
  for (int d0 = 0; d0 < 4; ++d0) { const int cb = (d0 * 16 + hi * 8) * 2;
    const bf16x8 b0 = *(LAS const bf16x8*)(Rs + RSWZ(r32, cb)), b1 = *(LAS const bf16x8*)(Rs + RSWZ(32 + r32, cb));
    p0 = __builtin_amdgcn_mfma_f32_32x32x16_bf16(b0, qr[8 + d0], p0, 0, 0, 0);
    p1 = __builtin_amdgcn_mfma_f32_32x32x16_bf16(b1, qr[8 + d0], p1, 0, 0, 0); }
}
__device__ __forceinline__ int v_st(int k, int c) { const int kk = (k & ~0xC) | ((k & 4) << 1) | ((k & 8) >> 1); return ((kk >> 3) * 4 + (c >> 5)) * 512 + ((kk & 7) * 32 + (c & 31)) * 2; }
__device__ __forceinline__ int v_rd_base(int lane) { return ((lane & 3) << 3) | (((lane >> 2) & 3) << 6) | (((lane >> 4) & 1) << 5) | (((lane >> 5) & 1) << 8); }
constexpr int v_rd_off(int d0, int ks, int half) { return d0 * 512 + ks * 4096 + half * 2048; }
template <int OFF> __device__ __forceinline__ s16x4 tr_read(int vb) {
  s16x4 r; asm volatile("ds_read_b64_tr_b16 %0, %1 offset:%2" : "=&v"(r) : "v"(vb), "i"(OFF) : "memory"); return r;
}
template <int D0> __device__ __forceinline__ void pv_one(f32x16& od, int vb, bf16x8 pa0, bf16x8 pa1, bf16x8 pa2, bf16x8 pa3) {
  const s16x4 l0 = tr_read<v_rd_off(D0, 0, 0)>(vb), h0 = tr_read<v_rd_off(D0, 0, 1)>(vb), l1 = tr_read<v_rd_off(D0, 1, 0)>(vb), h1 = tr_read<v_rd_off(D0, 1, 1)>(vb);
  const s16x4 l2 = tr_read<v_rd_off(D0, 2, 0)>(vb), h2 = tr_read<v_rd_off(D0, 2, 1)>(vb), l3 = tr_read<v_rd_off(D0, 3, 0)>(vb), h3 = tr_read<v_rd_off(D0, 3, 1)>(vb);
  asm volatile("s_waitcnt lgkmcnt(0)" ::: "memory"); SBAR();
#define PK(L, H) (bf16x8){L[0], L[1], L[2], L[3], H[0], H[1], H[2], H[3]}
  od = __builtin_amdgcn_mfma_f32_32x32x16_bf16(pa0, PK(l0, h0), od, 0, 0, 0);
  od = __builtin_amdgcn_mfma_f32_32x32x16_bf16(pa1, PK(l1, h1), od, 0, 0, 0);
  od = __builtin_amdgcn_mfma_f32_32x32x16_bf16(pa2, PK(l2, h2), od, 0, 0, 0);
  od = __builtin_amdgcn_mfma_f32_32x32x16_bf16(pa3, PK(l3, h3), od, 0, 0, 0);
#undef PK
}
__device__ __forceinline__ void pv_d0(f32x16* o, int vb, bf16x8 pa0, bf16x8 pa1, bf16x8 pa2, bf16x8 pa3) {
  pv_one<0>(o[0], vb, pa0, pa1, pa2, pa3); pv_one<1>(o[1], vb, pa0, pa1, pa2, pa3); pv_one<2>(o[2], vb, pa0, pa1, pa2, pa3); pv_one<3>(o[3], vb, pa0, pa1, pa2, pa3);
}
__device__ __forceinline__ void attn_unit(const bf16* __restrict__ Qb, const bf16* __restrict__ Kh, const bf16* __restrict__ Rh, const bf16* __restrict__ Vh, bf16* __restrict__ Ob, int seq, LAS unsigned char* lds, int wave) {
  int tid_ = wave * 64 + lane_id(); asm volatile("" : "+v"(tid_));
  const int tid = tid_, wid = tid >> 6, lane = tid & 63, r32 = lane & 31, hi = lane >> 5;
  LAS unsigned char* V_lds = lds + OFF_V; LAS unsigned char* K_lds = lds + OFF_K; LAS unsigned char* R_lds = lds + OFF_R;
  LAS float* wsf = (LAS float*)(lds + OFF_WS) + wid * 64; LAS float* li_l = wsf; LAS float* al_l = wsf + 32;
  float m_reg = -1e30f, l_reg = 0; f32x16 o[4] = {}; bf16x8 qr[12];
  const bf16* Qw = Qb + (long)(wid * QBLK + r32) * LDQ + hi * 8;
#pragma unroll
  for (int d0 = 0; d0 < 12; ++d0) qr[d0] = *(const bf16x8*)(Qw + d0 * 16);
  const int sr = tid >> 4, sc = (tid & 15) * 8, vst0 = v_st(sr, sc), vst1 = v_st(32 + sr, sc), rr = tid >> 3, rc = (tid & 7) * 8;
  const int vb0 = (int)(unsigned)(uintptr_t)V_lds + v_rd_base(lane);
  bf16x8 vs0, vs1, ks0, ks1, rs0;
#define SLOAD(k0) do { vs0 = *(const bf16x8*)&Vh[(long)((k0) + sr) * LDK + sc]; vs1 = *(const bf16x8*)&Vh[(long)((k0) + 32 + sr) * LDK + sc]; \
    ks0 = *(const bf16x8*)&Kh[(long)((k0) + sr) * LDK + sc]; ks1 = *(const bf16x8*)&Kh[(long)((k0) + 32 + sr) * LDK + sc]; rs0 = *(const bf16x8*)&Rh[(long)((k0) + rr) * LDR + rc]; } while (0)
#define SWRITE(b) do { *(LAS bf16x8*)(V_lds + (b) * SHM_V + vst0) = vs0; *(LAS bf16x8*)(V_lds + (b) * SHM_V + vst1) = vs1; \
    *(LAS bf16x8*)(K_lds + (b) * SHM_K + KSWZ(sr, sc * 2)) = ks0; *(LAS bf16x8*)(K_lds + (b) * SHM_K + KSWZ(32 + sr, sc * 2)) = ks1; \
    *(LAS bf16x8*)(R_lds + (b) * SHM_R + RSWZ(rr, rc * 2)) = rs0; } while (0)
#define SWAIT() asm volatile("s_waitcnt vmcnt(0)" ::: "memory")
#define RESC(a) do { if (__any((a) < 1.f)) { if (hi == 0) al_l[r32] = (a); asm volatile("s_waitcnt lgkmcnt(0)" ::: "memory"); \
    _Pragma("unroll") for (int d = 0; d < 4; ++d) _Pragma("unroll") for (int r = 0; r < 16; ++r) o[d][r] *= al_l[crow(r, hi)]; } } while (0)
  f32x16 pA0, pA1, pB0, pB1; float mnA, mnB, alA, alB; bf16x8 pa0, pa1, pa2, pa3; const int NT = seq / KVBLK;
  SLOAD(0); SWAIT(); SWRITE(0); __syncthreads();
  qkt(pA0, pA1, K_lds, R_lds, qr, r32, hi); partialSM(pA0, pA1, m_reg, mnA, alA);
  SLOAD(KVBLK);
  SWAIT(); SWRITE(1); __syncthreads();
  for (int j = 1; j + 1 < NT; j += 2) {
    SBAR(); qkt(pB0, pB1, K_lds + SHM_K, R_lds + SHM_R, qr, r32, hi);
    finishSM(pA0, pA1, alA, l_reg, pa0, pa1, pa2, pa3); SBAR();
    SLOAD((j + 1) * KVBLK); SBAR();
    pv_d0(o, vb0, pa0, pa1, pa2, pa3); partialSM(pB0, pB1, m_reg, mnB, alB);
    __syncthreads(); SWAIT(); SWRITE(0);
    RESC(alB); __syncthreads();
    SBAR(); qkt(pA0, pA1, K_lds, R_lds, qr, r32, hi);
    finishSM(pB0, pB1, alB, l_reg, pa0, pa1, pa2, pa3); SBAR();
    SLOAD((j + 2) * KVBLK); SBAR();
    pv_d0(o, vb0 + SHM_V, pa0, pa1, pa2, pa3); partialSM(pA0, pA1, m_reg, mnA, alA);
    __syncthreads(); SWAIT(); SWRITE(1);
    RESC(alA); __syncthreads();
  }
  SBAR(); qkt(pB0, pB1, K_lds + SHM_K, R_lds + SHM_R, qr, r32, hi);
  finishSM(pA0, pA1, alA, l_reg, pa0, pa1, pa2, pa3); SBAR();
  pv_d0(o, vb0, pa0, pa1, pa2, pa3); partialSM(pB0, pB1, m_reg, mnB, alB);
  __syncthreads(); RESC(alB);
  finishSM(pB0, pB1, alB, l_reg, pa0, pa1, pa2, pa3); SBAR();
  pv_d0(o, vb0 + SHM_V, pa0, pa1, pa2, pa3);
  if (hi == 0) li_l[r32] = l_reg; asm volatile("s_waitcnt lgkmcnt(0)" ::: "memory");
  float rli[16];
#pragma unroll
  for (int r = 0; r < 16; ++r) rli[r] = __builtin_amdgcn_rcpf(li_l[crow(r, hi)]);
  bf16* Ow = Ob + (long)(wid * QBLK) * LDO;
#pragma unroll
  for (int r = 0; r < 16; ++r) { const int orow = crow(r, hi);
#pragma unroll
    for (int d0 = 0; d0 < 4; ++d0) Ow[(long)orow * LDO + d0 * 32 + r32] = (bf16)f2bf(o[d0][r] * rli[r]); }
  __syncthreads();
#undef SLOAD
#undef SWRITE
#undef SWAIT
#undef RESC
}
}

__device__ __forceinline__ void attn_phase(Ctx& F) {
    const bf16* q = (const bf16*)(F.ws + T_Q); const bf16* kn = (const bf16*)(F.ws + T_KN); const bf16* kra = (const bf16*)(F.ws + T_KRA); const bf16* vv = (const bf16*)(F.ws + T_VV); bf16* o = (bf16*)(F.ws + WS_H);
    for (int un = blockIdx.x; un < 384; un += F.G) {
        int qrow0, krow0, h, seq;
        if (un < 256) { const int b = un >> 5, qb = (un >> 3) & 3; h = un & 7; qrow0 = MCTX + b * 1024 + qb * 256; krow0 = MCTX + b * 1280; seq = 1280; }
        else { const int v = un - 256, b = v >> 3; h = v & 7; qrow0 = b * 256; krow0 = b * 256; seq = 256; }
        att::attn_unit(q + (size_t)qrow0 * 1536 + h * 192, kn + (size_t)krow0 * 1024 + h * 128, kra + (size_t)krow0 * 64, vv + (size_t)krow0 * 1024 + h * 128, o + (size_t)qrow0 * 1024 + h * 128, seq, F.lds, F.wave);
    }
}

__global__ void __launch_bounds__(512, 2) mk_fwd(Args args) {
    extern __shared__ __attribute__((aligned(16))) unsigned char lds_raw[];
    Ctx F;
    F.lds = (LAS unsigned char*)lds_raw; F.wave = __builtin_amdgcn_readfirstlane((int)threadIdx.x >> 6); F.lane = 0; F.tid = 0; F.G = gridDim.x;
    F.gw = blockIdx.x * 8 + F.wave; F.NGW = F.G * 8; F.gt = 0; F.NT = F.G * 512;
    F.in = args.in; F.out = args.out; F.ws = args.ws;
    volatile LAS unsigned* MISC = (volatile LAS unsigned*)(F.lds + MISC_OFF);
    { const int t0 = F.wave * 64 + lane_id(); if (t0 < 32) MISC[t0] = 0u; }
    __syncthreads();
    const int lo = args.ph_lo, hi = args.ph_hi;
    XcdBarrier bar; bar.bar = (unsigned*)(F.ws + WS_CTL) + CW_BAR; bar.x = 0; bar.st = MISC + 8;
    if (hi - lo > 1) bar = xcd_barrier_post((unsigned*)(F.ws + WS_CTL) + CW_BAR, MISC + 8, F.wave * 64 + lane_id());
    int ph = 0, l_ = 0;
#ifndef MK_SP2
#define MK_SP2 true
#endif
#ifndef MK_MASK
#define MK_MASK 0xffffffffu
#endif
#define RUN(id, ...) do { if (lo <= ph && ph < hi) { if constexpr (((MK_MASK) >> (id)) & 1u) { { int t_ = F.wave * 64 + lane_id(), z_ = 0; asm volatile("" : "+v"(t_), "+s"(z_)); F.tid = t_; F.lane = t_ & 63; F.gt = blockIdx.x * 512 + t_; F.in = args.in + z_; unsigned long long pw_ = (unsigned long long)args.ws, po_ = (unsigned long long)args.out; asm volatile("" : "+s"(pw_), "+s"(po_)); F.ws = (unsigned char*)pw_; F.out = (float*)po_; } \
        unsigned char* ws = F.ws; const float* const* in = F.in; bf16* H = (bf16*)(ws + WS_H); float* VT = (float*)(ws + WS_VTMP); float* X = F.out; const float* modl = mod_layer(F, l_); \
        const float* xlo = (l_ == 0) ? in[I_XP] : X; const float* xhi = (l_ == 0) ? in[I_XS] : X + (size_t)MCTX * DM; (void)H; (void)VT; (void)modl; (void)xlo; (void)xhi; __VA_ARGS__; } if (ph + 1 < hi) xcd_barrier(bar, F.wave * 64 + lane_id()); } ++ph; } while (0)
#define GEMM(EpiT, E, Aptr, Bptr, M_, N_, K_, lda_, ash_) do { Gemm<K_, lda_, ash_> g{(const bf16_t*)(Aptr), (const bf16_t*)(Bptr)}; StaticOrder S; S.init(M_, N_, F.G, (int)blockIdx.x, F.wave); \
        gemm_phase<EpiT, StaticOrder, true, MK_SP2, Gemm<K_, lda_, ash_>>(F.lds, g, S, E); } while (0)

    RUN(0, p0_prologue(F));
    for (int l = 0; l < 4; ++l) {
        l_ = l;
        const int kind = l % 3;
        if (kind == 0) {
            const int j = l / 3;
            RUN(1, pool_ew_phase(F, xlo, xhi, modl, H));
            RUN(2, { EpiResid E{xlo, xhi, VT, modl + 2 * 1024, in[I_PSCALE] + j * 1024}; GEMM(EpiResid, E, H, (bf16*)(ws + W_POOL) + (size_t)j * 4 * 65536, MT, 1024, 256, 1024, 0); });
        } else if (kind == 1) {
            RUN(3, { EpiF32 E{(float*)(ws + T_RAW), 768}; GEMM(EpiF32, E, H, ws + W_DQKV, MT, 768, 1024, 1024, -1); });
            RUN(4, mla_post_phase(F));
            RUN(5, { { EpiQ E{(bf16*)(ws + T_Q), (const float*)(ws + WS_ROPE)}; GEMM(EpiQ, E, ws + T_QN, ws + W_UQ, MT, 1536, 384, 384, -1); }
                  { EpiKV E{(bf16*)(ws + T_KN), (bf16*)(ws + T_VV)}; GEMM(EpiKV, E, ws + T_CKV, ws + W_UKV, KROWS, 2048, 256, 256, -1); } });
            RUN(6, attn_phase(F));
            RUN(7, { EpiResid E{xlo, xhi, VT, modl + 2 * 1024, nullptr}; GEMM(EpiResid, E, H, ws + W_O, MT, 1024, 1024, 1024, -1); });
        } else {
            RUN(8, { EpiLruIn E{VT, (bf16*)(ws + T_Y)}; GEMM(EpiLruIn, E, H, ws + W_LIN, MT, 2048, 1024, 1024, -1); });
            RUN(9, lru_conv_phase(F));
            RUN(10, { EpiGates E{(const bf16*)(ws + T_UCONV), in[I_BLA], in[I_BLI], (const float*)(ws + WS_SP), (float*)(ws + T_AF), (float*)(ws + T_AB), (bf16*)(ws + T_BF), (bf16*)(ws + T_BB)};
                  GEMM(EpiGates, E, ws + T_UCONV, ws + W_GATE, MT, 4096, 256, 1024, 2); });
            RUN(11, lru_scan1_phase(F));
            RUN(12, lru_scan2_phase(F));
            RUN(13, { EpiResid E{xlo, xhi, VT, modl + 2 * 1024, nullptr}; GEMM(EpiResid, E, H, ws + W_LOUT, MT, 1024, 1024, 1024, -1); });
        }
        RUN(14, ln_phase(F, VT, X, H, in[I_LNG] + (l * 2 + 0) * 1024, in[I_LNB] + (l * 2 + 0) * 1024, modl, 3, 4));
        RUN(15, { EpiSwiGLU E{(bf16*)(ws + T_ACT)}; GEMM(EpiSwiGLU, E, H, (bf16*)(ws + W_FFN_IN) + (size_t)l * 5632 * 1024, MT, 5632, 1024, 1024, -1); });
        RUN(16, { EpiResid E{X, X + (size_t)MCTX * DM, VT, modl + 5 * 1024, nullptr}; GEMM(EpiResid, E, ws + T_ACT, (bf16*)(ws + W_FFN_OUT) + (size_t)l * 1024 * DFF, MT, 1024, DFF, DFF, -1); });
        RUN(17, { const float* modn = mod_layer(F, l < 3 ? l + 1 : 3); bf16* hn = (l < 3 && (l + 1) % 3 != 0) ? H : nullptr;
                  ln_phase(F, VT, X, hn, in[I_LNG] + (l * 2 + 1) * 1024, in[I_LNB] + (l * 2 + 1) * 1024, modn, 0, 1); });
    }
#undef RUN
#undef GEMM
}

extern "C" void kernel_launch(void* const* d_in, const int* in_sizes, int n_in, void* d_out, int out_size, void* d_ws, size_t ws_size, hipStream_t stream) {
    static int grid = 0;
    if (grid == 0) {
        if (n_in != 32 || out_size != (int)O_END || ws_size < WS_END) { fprintf(stderr, "kernel_launch: unexpected problem: n_in %d out %d ws %zu (need >= %zu)\n", n_in, out_size, ws_size, (size_t)WS_END); grid = -1; return; }
        int dev = 0, cus = 0, per_cu = 0;
        if (hipGetDevice(&dev) != hipSuccess || hipDeviceGetAttribute(&cus, hipDeviceAttributeMultiprocessorCount, dev) != hipSuccess) { grid = -1; return; }
        if (hipFuncSetAttribute((const void*)mk_fwd, hipFuncAttributeMaxDynamicSharedMemorySize, LDS_BYTES) != hipSuccess) { fprintf(stderr, "kernel_launch: hipFuncSetAttribute failed\n"); grid = -1; return; }
        if (hipOccupancyMaxActiveBlocksPerMultiprocessor(&per_cu, (const void*)mk_fwd, 512, LDS_BYTES) != hipSuccess || per_cu < 1) { fprintf(stderr, "kernel_launch: occupancy query says %d\n", per_cu); per_cu = 1; }
        (void)hipGetLastError();
        grid = cus;
    }
    if (grid < 0) return;
    (void)hipMemsetAsync((char*)d_ws + WS_CTL, 0, CTL_ZERO_BYTES, stream);
    Args a{};
    for (int i = 0; i < 32; ++i) a.in[i] = (const float*)d_in[i];
    a.out = (float*)d_out; a.ws = (unsigned char*)d_ws;
#ifndef MK_ONE_LAUNCH
#define MK_ONE_LAUNCH 1
#endif
    if (MK_ONE_LAUNCH) { a.ph_lo = 0; a.ph_hi = NPHASE; hipLaunchKernelGGL(mk_fwd, dim3(grid), dim3(512), LDS_BYTES, stream, a); }
    else for (int p = 0; p < NPHASE; ++p) { a.ph_lo = p; a.ph_hi = p + 1; hipLaunchKernelGGL(mk_fwd, dim3(grid), dim3(512), LDS_BYTES, stream, a); }
}
```
